# Optimizing an MI355X kernel written in HIP

```python
import jax, jax.numpy as jnp
from jax import lax
import numpy as np

D_MODEL = 2048
BATCH = 8
SEQ = 2048
DEPTH = 1

CTX_LEN = 256
GRID_W = 64
HEAD_DIM = 128
N_HEADS = 8
N_KV_HEADS = 2
Q_BLOCK = 128
ROPE_THETA = 10000.0
AXIS_DIM = HEAD_DIM // 2
ATTN_SCALE = HEAD_DIM ** -0.5
GM_GROUPS = 8
GM_GROUP_DIM = 128
CHUNK = 128
N_BRANCHES = 2
Q_W = N_HEADS * HEAD_DIM
KV_W = N_KV_HEADS * HEAD_DIM
GM_W = GM_GROUPS * GM_GROUP_DIM
IN_W = 2 * KV_W + Q_W + 2 * GM_W + N_BRANCHES * D_MODEL
N_GROUPS = 4
EXPERTS_PER_GROUP = 8
N_EXPERTS = N_GROUPS * EXPERTS_PER_GROUP
TOP_K = 2
D_EXPERT = D_MODEL // 2
N_MOD = 6
EPS = 1e-6

kernel_name = "hybrid_gated_gmlp_axial_gqa_hmoe_block"


def rms_norm(x, g):
    xf = x.astype(jnp.float32)
    y = xf * lax.rsqrt(jnp.mean(jnp.square(xf), axis=-1, keepdims=True) + EPS)
    return (y * g.astype(jnp.float32)).astype(x.dtype)


def layer_norm(x, g):
    xf = x.astype(jnp.float32)
    xc = xf - jnp.mean(xf, axis=-1, keepdims=True)
    y = xc * lax.rsqrt(jnp.mean(jnp.square(xc), axis=-1, keepdims=True) + EPS)
    return (y * g.astype(jnp.float32)).astype(x.dtype)


def adaln(cond, w, b, n):
    m = jax.nn.silu(cond) @ w[:, :n * D_MODEL] + b[:n * D_MODEL]
    return jnp.split(m[..., None, :], n, axis=-1)


def modulate(h, shift, scale):
    return h * (1.0 + scale) + shift


def axial_rope(rows):
    row = jnp.repeat(jnp.arange(rows, dtype=jnp.int32), GRID_W)
    col = jnp.tile(jnp.arange(GRID_W, dtype=jnp.int32), rows)
    inv_freq = ROPE_THETA ** (-jnp.arange(0, AXIS_DIM, 2, dtype=jnp.float32) / AXIS_DIM)
    pos = jnp.stack([row, col], axis=-1).astype(jnp.float32)
    ang = pos[:, :, None] * inv_freq
    return jnp.cos(ang), jnp.sin(ang)


def apply_rope(x, cos, sin):
    B, L, H, _ = x.shape
    xr = x.reshape(B, L, H, 2, 2, AXIS_DIM // 2)
    x1, x2 = xr[..., 0, :], xr[..., 1, :]
    cs = cos[None, :, None].astype(x.dtype)
    sn = sin[None, :, None].astype(x.dtype)
    out = jnp.stack([x1 * cs - x2 * sn, x2 * cs + x1 * sn], axis=-2)
    return out.reshape(B, L, H, HEAD_DIM)


def block_attention(q, k, v):
    B, Lq, _, _ = q.shape
    n_blk = Lq // Q_BLOCK
    grp = N_HEADS // N_KV_HEADS
    qb = q.reshape(B, n_blk, Q_BLOCK, N_KV_HEADS, grp, HEAD_DIM).transpose(1, 0, 2, 3, 4, 5)

    def attend(q_blk):
        s = jnp.einsum('bqkgd,bskd->bkgqs', q_blk, k).astype(jnp.float32) * ATTN_SCALE
        p = jax.nn.softmax(s, axis=-1).astype(v.dtype)
        return jnp.einsum('bkgqs,bskd->bqkgd', p, v)

    o = lax.map(attend, qb)
    return o.transpose(1, 0, 2, 3, 4, 5).reshape(B, Lq, N_HEADS * HEAD_DIM)


def chunk_spatial_gating(u, v, ln_g, w_s, b_s):
    B, L, _ = u.shape
    n = L // CHUNK
    vn = layer_norm(v.reshape(B, L, GM_GROUPS, GM_GROUP_DIM), ln_g.reshape(GM_GROUPS, GM_GROUP_DIM))
    vc = vn.reshape(B, n, CHUNK, GM_GROUPS, GM_GROUP_DIM)
    s = jnp.einsum('gpq,bnqgc->bnpgc', w_s, vc) + b_s.T[:, :, None]
    return u * s.reshape(B, L, GM_W)


def project_kv(h, w_in, k_norm):
    B, L, _ = h.shape
    k, v = jnp.split(h @ w_in[:, :2 * KV_W], 2, axis=-1)
    k = rms_norm(k.reshape(B, L, N_KV_HEADS, HEAD_DIM), k_norm)
    return k, v.reshape(B, L, N_KV_HEADS, HEAD_DIM)


def project_rest(h, w_in, q_norm):
    B, L, _ = h.shape
    r = h @ w_in[:, 2 * KV_W:]
    q, u, vg, ga, gg = jnp.split(r, [Q_W, Q_W + GM_W, Q_W + 2 * GM_W, Q_W + 2 * GM_W + D_MODEL], axis=-1)
    q = rms_norm(q.reshape(B, L, N_HEADS, HEAD_DIM), q_norm)
    return q, u, vg, ga, gg


def merge_branches(attn, u, vg, ga, gg, gm_ln, w_s, b_s, w_ba, w_bg, w_o):
    gm = chunk_spatial_gating(jax.nn.gelu(u), jax.nn.gelu(vg), gm_ln, w_s, b_s)
    merged = jax.nn.sigmoid(ga) * (attn @ w_ba) + jax.nn.sigmoid(gg) * (gm @ w_bg)
    return merged @ w_o


def hier_moe(h, w_rg, b_rg, w_re, b_re, w_gate, w_up, w_down):
    B, L, D = h.shape
    t = h.reshape(B * L, D)
    tf = t.astype(jnp.float32)
    p_group = jax.nn.softmax(tf @ w_rg.astype(jnp.float32) + b_rg.astype(jnp.float32), axis=-1)
    p_top, g_idx = lax.top_k(p_group, 1)
    e_logits = jnp.einsum('nd,dge->nge', tf, w_re.astype(jnp.float32)) + b_re.astype(jnp.float32)
    sel = e_logits[jnp.arange(B * L), g_idx[:, 0]]
    p_two, e_idx = lax.top_k(jax.nn.softmax(sel, axis=-1), TOP_K)
    weight = p_top * p_two / jnp.sum(p_two, axis=-1, keepdims=True)
    expert_id = g_idx * EXPERTS_PER_GROUP + e_idx
    gates = jnp.einsum('nk,nke->ne', weight,
                       jax.nn.one_hot(expert_id, N_EXPERTS, dtype=jnp.float32)).astype(t.dtype)
    y = jnp.zeros_like(t)
    for e in range(N_EXPERTS):
        hid = jax.nn.silu(t @ w_gate[e]) * (t @ w_up[e])
        y = y + (gates[:, e:e + 1] * hid) @ w_down[e]
    return y.reshape(B, L, D)


def _normal(key, shape, scale):
    return jax.random.normal(key, shape, jnp.float32) * scale


def setup_inputs(seed: int = 0) -> dict:
    key = jax.random.key(seed)
    ks = jax.random.split(key, 26)
    D = D_MODEL
    return {
        "x": _normal(ks[0], (BATCH, SEQ, D), 1.0),
        "c": _normal(ks[1], (BATCH, D), 1.0),
        "ctx": _normal(ks[2], (BATCH, CTX_LEN, D), 1.0),
        "c_ctx": _normal(ks[3], (D,), 1.0),
        "w_ada": _normal(ks[4], (DEPTH, D, N_MOD * D), 0.5 * D ** -0.5),
        "b_ada": _normal(ks[5], (DEPTH, N_MOD * D), 0.02),
        "g_pre1": 1.0 + _normal(ks[6], (DEPTH, D), 0.05),
        "g_post1": 1.0 + _normal(ks[7], (DEPTH, D), 0.05),
        "g_pre2": 1.0 + _normal(ks[8], (DEPTH, D), 0.05),
        "g_post2": 1.0 + _normal(ks[9], (DEPTH, D), 0.05),
        "w_in": _normal(ks[10], (DEPTH, D, IN_W), D ** -0.5),
        "q_norm": 1.0 + _normal(ks[11], (DEPTH, HEAD_DIM), 0.05),
        "k_norm": 1.0 + _normal(ks[12], (DEPTH, HEAD_DIM), 0.05),
        "gm_ln": 1.0 + _normal(ks[13], (DEPTH, GM_W), 0.05),
        "w_s": _normal(ks[14], (DEPTH, GM_GROUPS, CHUNK, CHUNK), CHUNK ** -0.5),
        "b_s": 1.0 + _normal(ks[15], (DEPTH, GM_GROUPS, CHUNK), 0.05),
        "w_ba": _normal(ks[16], (DEPTH, Q_W, D), Q_W ** -0.5),
        "w_bg": _normal(ks[17], (DEPTH, GM_W, D), GM_W ** -0.5),
        "w_o": _normal(ks[18], (DEPTH, D, D), D ** -0.5),
        "w_rg": _normal(ks[19], (DEPTH, D, N_GROUPS), D ** -0.5),
        "b_rg": _normal(ks[20], (DEPTH, N_GROUPS), 0.01),
        "w_re": _normal(ks[21], (DEPTH, D, N_GROUPS, EXPERTS_PER_GROUP), D ** -0.5),
        "b_re": _normal(ks[22], (DEPTH, N_GROUPS, EXPERTS_PER_GROUP), 0.01),
        "w_gate": _normal(ks[23], (DEPTH, N_EXPERTS, D, D_EXPERT), D ** -0.5),
        "w_up": _normal(ks[24], (DEPTH, N_EXPERTS, D, D_EXPERT), D ** -0.5),
        "w_down": _normal(ks[25], (DEPTH, N_EXPERTS, D_EXPERT, D), D_EXPERT ** -0.5),
    }


def reference(x, c, ctx, c_ctx, w_ada, b_ada, g_pre1, g_post1, g_pre2, g_post2, w_in, q_norm, k_norm,
              gm_ln, w_s, b_s, w_ba, w_bg, w_o, w_rg, b_rg, w_re, b_re, w_gate, w_up, w_down):
    rows = x.shape[1] // GRID_W
    cos, sin = axial_rope(rows)
    for l in range(DEPTH):
        last = l + 1 == DEPTH
        sh1, sc1, g1, sh2, sc2, g2 = adaln(c, w_ada[l], b_ada[l], N_MOD)
        ctx_mod = adaln(c_ctx, w_ada[l], b_ada[l], 2 if last else N_MOD)

        hc = modulate(rms_norm(ctx, g_pre1[l]), ctx_mod[0], ctx_mod[1])
        hx = modulate(rms_norm(x, g_pre1[l]), sh1, sc1)
        kc, vc = project_kv(hc, w_in[l], k_norm[l])
        kx, vx = project_kv(hx, w_in[l], k_norm[l])
        qx, ux, vgx, gax, ggx = project_rest(hx, w_in[l], q_norm[l])
        qx = apply_rope(qx, cos, sin)
        kx = apply_rope(kx, cos, sin)
        attn_x = block_attention(qx, jnp.concatenate([kc, kx], axis=1), jnp.concatenate([vc, vx], axis=1))
        mix_x = merge_branches(attn_x, ux, vgx, gax, ggx, gm_ln[l], w_s[l], b_s[l], w_ba[l], w_bg[l], w_o[l])
        x = x + g1 * rms_norm(mix_x, g_post1[l])

        moe_x = hier_moe(modulate(rms_norm(x, g_pre2[l]), sh2, sc2),
                         w_rg[l], b_rg[l], w_re[l], b_re[l], w_gate[l], w_up[l], w_down[l])
        x = x + g2 * rms_norm(moe_x, g_post2[l])

        if not last:
            csh1, csc1, cg1, csh2, csc2, cg2 = ctx_mod
            qc, uc, vgc, gac, ggc = project_rest(hc, w_in[l], q_norm[l])
            attn_c = block_attention(qc, kc, vc)
            mix_c = merge_branches(attn_c, uc, vgc, gac, ggc, gm_ln[l], w_s[l], b_s[l], w_ba[l], w_bg[l], w_o[l])
            ctx = ctx + cg1 * rms_norm(mix_c, g_post1[l])
            moe_c = hier_moe(modulate(rms_norm(ctx, g_pre2[l]), csh2, csc2),
                             w_rg[l], b_rg[l], w_re[l], b_re[l], w_gate[l], w_up[l], w_down[l])
            ctx = ctx + cg2 * rms_norm(moe_c, g_post2[l])
    return x
```

```cpp
#include <hip/hip_runtime.h>
#include <cstdio>
#include <cstdint>

#define LAS __attribute__((address_space(3)))
#define GAS __attribute__((address_space(1)))
typedef unsigned short bf16_t;
typedef short bf16x8 __attribute__((ext_vector_type(8)));
typedef short s16x4 __attribute__((ext_vector_type(4)));
typedef float f32x4 __attribute__((ext_vector_type(4)));
typedef float f32x2 __attribute__((ext_vector_type(2)));
typedef float f32x16 __attribute__((ext_vector_type(16)));
typedef unsigned u32x4 __attribute__((ext_vector_type(4)));
typedef unsigned u32x2 __attribute__((ext_vector_type(2)));
typedef int i32x4 __attribute__((ext_vector_type(4)));

constexpr int NCONV8 = 3;
#ifndef MK_N_LAUNCHES
#define MK_N_LAUNCHES 1
#endif
constexpr int N_PHASES = 11;

constexpr int DM = 2048, NB = 8, SEQ = 2048, NTOK = NB * SEQ, CTXL = 256, NCTX = NB * CTXL, NROW = NTOK + NCTX, LK = CTXL + SEQ;
constexpr int NH = 8, NKV = 2, HD = 128, QW = 1024, KVW = 256, GMW = 1024, INW = 7680, NEXP = 32, DEXP = 1024, CAP = NTOK;
constexpr int NMOD = 6 * DM;
constexpr float EPS = 1e-6f;
constexpr float ATT_QSC = 0.088388347648318440f * 1.4426950408889634f;
constexpr int NWAVES = 8, NTHR = 512;

constexpr size_t MiB = 1u << 20;
constexpr size_t WS_CTL = 0, CTL_ZERO_BYTES = 65536;
constexpr size_t WS_MODP = 1 * MiB;
constexpr size_t WS_MODF = 3 * MiB;
constexpr size_t WS_ROPE = WS_MODF + 262144;
constexpr size_t WS_XSQ = WS_ROPE + 16384;
constexpr size_t WS_WRF = WS_XSQ + 65536;
constexpr size_t WS_WSB = WS_WRF + 393216;
constexpr size_t WS_SA = 4 * MiB, WS_SAH = WS_SA + 131072, WS_SBIN = WS_SAH + 131072, WS_SBGU = WS_SBIN + 262144, WS_SBDN = WS_SBGU + 262144, WS_SAHID = WS_SBDN + 262144, WS_SBWO = WS_SAHID + 262144, WS_SAMG = WS_SBWO + 65536, WS_SBBA = WS_SAMG + 65536, WS_SBBG = WS_SBBA + 8192, WS_SAATT = WS_SBBG + 8192, WS_SAGM = WS_SAATT + 65536;
constexpr size_t WS_LTOK = 6 * MiB, WS_LW = 8 * MiB, WS_TSLOT = 10 * MiB;
constexpr size_t WS_STAT = 11 * MiB;
constexpr size_t WS_XCH = 12 * MiB, WS_XCH2 = WS_XCH + (size_t)160 * 8 * 256 * 8, WS_XCH_END = WS_XCH2 + (size_t)64 * 8 * 256 * 8;
constexpr size_t WS_WIN = 20 * MiB, WS_WBA = 50 * MiB, WS_WBG = 54 * MiB, WS_WO = 58 * MiB, WS_WGU = 66 * MiB, WS_WDN = 322 * MiB;
constexpr size_t WS_ACT = 450 * MiB;
constexpr size_t WS_HX = WS_ACT, WS_H2 = WS_ACT;

constexpr size_t WS_Q = WS_ACT + 72 * MiB, WS_KRAW = WS_Q + 32 * MiB, WS_KN = WS_KRAW + 9 * MiB, WS_V = WS_KN + 9 * MiB, WS_U = WS_V + 9 * MiB, WS_VG = WS_U + 32 * MiB,
                 WS_GA = WS_VG + 32 * MiB, WS_GG = WS_GA + 64 * MiB, WS_ATT = WS_GG + 64 * MiB, WS_GM = WS_ATT + 32 * MiB, WS_MG = WS_GM + 32 * MiB, WS_MIX = WS_MG + 64 * MiB,
                 WS_END = WS_MIX + 128 * MiB;
constexpr size_t WS_HID = WS_Q, WS_Y = WS_HID + 80 * MiB;
constexpr size_t WS_ATT8 = WS_Q, WS_GM8 = WS_Q + 16 * MiB;
static_assert(WS_SAGM + 65536 <= 6 * MiB, "scale map");
constexpr size_t WS_X1 = WS_MIX + 64 * MiB;
constexpr size_t WS_MG8 = WS_END, WS_END2 = WS_END + 32 * MiB;
static_assert(WS_Y + 160 * MiB <= WS_ATT, "moe overlay");
constexpr int CW_TMO = 0, CW_BAR = 4096, CW_WORK = 8192, CW_STRIP = 8320, CW_WORK2 = 8448, CW_STRIP2 = 8512, CW_QA = 8576, CW_QB = 9088, CW_CNT = 9728, CW_XC = 13824, CW_XC2 = 12800, CW_STRIP3 = 12672;

constexpr int RING_BYTES = 131072;
constexpr int LDS_MISC = 163840 - 64;
constexpr int LDS_TAB = RING_BYTES + 64;
constexpr int MAXU = 6;
constexpr int TAB_ROWOFF = LDS_TAB;
constexpr int TAB_W = TAB_ROWOFF + MAXU * 1024;
constexpr int TAB_SA = TAB_W + MAXU * 1024;
constexpr int TAB_UDESC = TAB_SA + MAXU * 1024;
constexpr int TAB_CNT = TAB_UDESC + MAXU * 16 + 32;
constexpr int TAB_TBASE = TAB_CNT + 128;
constexpr int TAB_TILEE = TAB_TBASE + 144;
constexpr int XCH_M = 151552, XCH_R = 155648;
constexpr int PRE_OFF = 156672;
constexpr int LDS_BYTES = 163840;
static_assert(TAB_TILEE + 640 <= LDS_MISC, "lds map");

#define RLX_AGENT __ATOMIC_RELAXED, __HIP_MEMORY_SCOPE_AGENT
#define LDS_WAIT() asm volatile("s_waitcnt lgkmcnt(0)" ::: "memory")
#define VM_WAIT() asm volatile("s_waitcnt vmcnt(0)" ::: "memory")
__device__ __forceinline__ unsigned cvt_pk_bf16(float lo, float hi) { unsigned r; asm volatile("v_cvt_pk_bf16_f32 %0, %1, %2" : "=v"(r) : "v"(lo), "v"(hi)); return r; }
__device__ __forceinline__ float bf_lo(unsigned w) { return __uint_as_float(w << 16); }
__device__ __forceinline__ float bf_hi(unsigned w) { return __uint_as_float(w & 0xffff0000u); }
__device__ __forceinline__ float bf1(bf16_t h) { return __uint_as_float(((unsigned)h) << 16); }
__device__ __forceinline__ float fexp2(float x) { return __builtin_amdgcn_exp2f(x); }
__device__ __forceinline__ float frcp(float x) { return __builtin_amdgcn_rcpf(x); }
__device__ __forceinline__ float sigmoidf_(float x) { return frcp(1.0f + fexp2(-1.4426950408889634f * x)); }
__device__ __forceinline__ float siluf_(float x) { return x * sigmoidf_(x); }
__device__ __forceinline__ float gelu_tanh(float x) { const float u = x * (1.0f + 0.044715f * x * x); return x * frcp(1.0f + fexp2(-2.302208198f * u)); }
__device__ __forceinline__ unsigned q8x4(f32x4 v) {
    const int a = (int)rintf(v.x), b = (int)rintf(v.y), c = (int)rintf(v.z), d = (int)rintf(v.w);
    return ((unsigned)a & 0xffu) | (((unsigned)b & 0xffu) << 8) | (((unsigned)c & 0xffu) << 16) | ((unsigned)d << 24); }
__device__ __forceinline__ unsigned q8x4m(f32x4 v, float sc) {
    const unsigned t0 = __float_as_uint(fmaf(v.x, sc, 12582912.0f)), t1 = __float_as_uint(fmaf(v.y, sc, 12582912.0f)), t2 = __float_as_uint(fmaf(v.z, sc, 12582912.0f)), t3 = __float_as_uint(fmaf(v.w, sc, 12582912.0f));
    return __builtin_amdgcn_perm(t1, t0, 0x0c0c0400u) | __builtin_amdgcn_perm(t3, t2, 0x04000c0cu); }
template <int CTRL> __device__ __forceinline__ float dppf(float v) { return __int_as_float(__builtin_amdgcn_update_dpp(0, __float_as_int(v), CTRL, 0xf, 0xf, true)); }
__device__ __forceinline__ float psum16(float v) { auto r = __builtin_amdgcn_permlane16_swap(__float_as_uint(v), __float_as_uint(v), false, false); return __uint_as_float(r[0]) + __uint_as_float(r[1]); }
__device__ __forceinline__ float psum32(float v) { auto r = __builtin_amdgcn_permlane32_swap(__float_as_uint(v), __float_as_uint(v), false, false); return __uint_as_float(r[0]) + __uint_as_float(r[1]); }
__device__ __forceinline__ float pmax16(float v) { auto r = __builtin_amdgcn_permlane16_swap(__float_as_uint(v), __float_as_uint(v), false, false); return fmaxf(__uint_as_float(r[0]), __uint_as_float(r[1])); }
__device__ __forceinline__ float pmax32(float v) { auto r = __builtin_amdgcn_permlane32_swap(__float_as_uint(v), __float_as_uint(v), false, false); return fmaxf(__uint_as_float(r[0]), __uint_as_float(r[1])); }
__device__ __forceinline__ float wave_sum(float v) {
    v += dppf<0xB1>(v); v += dppf<0x4E>(v); v += dppf<0x141>(v); v += dppf<0x140>(v);
    return psum32(psum16(v));
}
__device__ __forceinline__ float wave_max(float v) {
    v = fmaxf(v, dppf<0xB1>(v)); v = fmaxf(v, dppf<0x4E>(v)); v = fmaxf(v, dppf<0x141>(v)); v = fmaxf(v, dppf<0x140>(v));
    return pmax32(pmax16(v));
}

#define XB_TMO      128
#define XB_XCNT(j)  (256  + 64 * (j))
#define XB_XSUB(j)  (1280 + 64 * (j))
#define XB_XGEN(j)  (2304 + 64 * (j))
#define XB_TOP      3328
#define XB_TOPGEN   3392
#define XCD_BAR_WORDS 3456
#define XB_SPIN_CAP (1u << 18)
__device__ __forceinline__ unsigned xb_ld(unsigned* p)              { return __hip_atomic_load(p, __ATOMIC_RELAXED, __HIP_MEMORY_SCOPE_AGENT); }
__device__ __forceinline__ unsigned xb_add(unsigned* p, unsigned v) { return __hip_atomic_fetch_add(p, v, __ATOMIC_RELAXED, __HIP_MEMORY_SCOPE_AGENT); }
__device__ __forceinline__ unsigned xb_xcc_id() { return (unsigned)__builtin_amdgcn_s_getreg((3 << 11) | 20) & 0xFu; }
#define XB_SPIN(cond, bar) do { unsigned _sp = 0; while (cond) { __builtin_amdgcn_s_sleep(1); \
    if ((++_sp & 255u) == 0u) { if (xb_ld(&(bar)[XB_TMO])) break; if (_sp > XB_SPIN_CAP) { atomicAdd(&(bar)[XB_TMO], 1u); break; } } } } while (0)
struct XcdBarrier { unsigned* bar; unsigned x; volatile LAS unsigned* st; };
__device__ __forceinline__ XcdBarrier xcd_barrier_post(unsigned* bar, volatile LAS unsigned* st) {
    XcdBarrier b; b.bar = bar; b.x = xb_xcc_id(); b.st = st;
    if (threadIdx.x == 0) (void)xb_add(&bar[XB_XCNT(b.x)], 1u);
    return b;
}
__device__ __forceinline__ void xcd_barrier_complete(unsigned* bar, unsigned x, unsigned& nloc, unsigned& nx) {
    const unsigned G = gridDim.x * gridDim.y * gridDim.z;
    unsigned sum, cnt, mine, sp = 0u;
    for (;;) {
        sum = 0u; cnt = 0u; mine = 0u;
#pragma unroll
        for (unsigned j = 0; j < 16; ++j) { const unsigned c = xb_ld(&bar[XB_XCNT(j)]); sum += c; cnt += (c > 0u) ? 1u : 0u; mine = (j == x) ? c : mine; }
        if (sum == G) break;
        __builtin_amdgcn_s_sleep(1);
        if ((++sp & 255u) == 0u) { if (xb_ld(&bar[XB_TMO])) break; if (sp > XB_SPIN_CAP) { atomicAdd(&bar[XB_TMO], 1u); break; } }
    }
    nloc = mine > 0u ? mine : 1u; nx = cnt > 0u ? cnt : 1u;
}
__device__ __forceinline__ void xcd_barrier(const XcdBarrier& b) {
    asm volatile("s_waitcnt vmcnt(0)" ::: "memory");
    __syncthreads();
    if (threadIdx.x == 0) {
        unsigned* bar = b.bar;
        __builtin_amdgcn_s_waitcnt(0);
        unsigned nloc = b.st[0], nx = b.st[1];
        if (nloc == 0u) { xcd_barrier_complete(bar, b.x, nloc, nx); b.st[0] = nloc; b.st[1] = nx; }
        const unsigned old = xb_add(&bar[XB_XSUB(b.x)], 1u);
        const unsigned gen = old / nloc;
        if (old + 1u == (gen + 1u) * nloc) {
            __builtin_amdgcn_fence(__ATOMIC_RELEASE, "agent");
            asm volatile("s_waitcnt vmcnt(0)" ::: "memory");
            const unsigned og = xb_add(&bar[XB_TOP], 1u);
            const unsigned tg = og / nx;
            if (og + 1u == (tg + 1u) * nx) xb_add(&bar[XB_TOPGEN], 1u);
            else XB_SPIN(xb_ld(&bar[XB_TOPGEN]) == tg, bar);
            __builtin_amdgcn_fence(__ATOMIC_ACQUIRE, "agent");
            xb_add(&bar[XB_XGEN(b.x)], 1u);
            asm volatile("s_waitcnt vmcnt(0)" ::: "memory");
        } else {
            XB_SPIN(xb_ld(&bar[XB_XGEN(b.x)]) == gen, bar);
            __builtin_amdgcn_fence(__ATOMIC_ACQUIRE, "agent");
            asm volatile("s_waitcnt vmcnt(0)" ::: "memory");
        }
    }
    __syncthreads();
}

namespace pg8 {
constexpr int BM = 256, BK = 64, HALF = 128, HTB = HALF * BK * 2, STAGE_BYTES = 8 * HTB, NXCD = 8, WGM = 8;
__device__ __forceinline__ int lds_byte(int r, int c) { const int st = (r >> 4) * 2 + (c >> 5), rr = r & 15, cc = c & 31, ob = rr * 64 + cc * 2; return st * 1024 + (ob ^ (((ob >> 9) & 1) << 5)); }
__device__ __forceinline__ void stage_rc(int b, int& R, int& C) { const int st = b / 1024, sb = b % 1024, swz = sb ^ (((sb >> 9) & 1) << 5); R = (st >> 1) * 16 + swz / 64; C = (st & 1) * 32 + (swz % 64) / 2; }
__device__ __forceinline__ int perm32(int rho) { const int n = rho >> 4, i = rho & 15; return 8 * (i >> 2) + 4 * n + (i & 3); }

struct Unit { const char* a; const char* b; int pm, pn, e, slot; };

__device__ __forceinline__ void static_map(int L, int nM, int nN, int& pm, int& pn) {
    const int nwg = nM * nN; int wgid = L;
    { const int q = nwg / NXCD, r = nwg % NXCD, xcd = wgid % NXCD, off = wgid / NXCD; wgid = (xcd < r ? xcd * (q + 1) : r * (q + 1) + (xcd - r) * q) + off; }
    const int nig = WGM * nN, gid = wgid / nig, fm = gid * WGM, gsz = (nM - fm) < WGM ? (nM - fm) : WGM;
    pm = fm + ((wgid % nig) % gsz); pn = (wgid % nig) / gsz;
}

template <bool I8> struct AccSel { typedef f32x4 T; };
template <> struct AccSel<true> { typedef i32x4 T; };
template <int ROWB, bool I8, bool GATHER, bool ALIGN_EPI, class Epi, class Sched>
__device__ __forceinline__ void gemm_phase(LAS unsigned char* lds, const Sched& S, const Epi& E) {
    const int tid = threadIdx.x, wid = __builtin_amdgcn_readfirstlane(tid >> 6), lane = tid & 63, wr = wid >> 2, wc = wid & 3, fr = lane & 15, fq = lane >> 4;
    constexpr int nt = ROWB / 128;
    typedef typename AccSel<I8>::T acc_t;
    unsigned voffA[2], voffB[2]; int rowA[2];
#pragma unroll
    for (int i = 0; i < 2; ++i) { int R, C; stage_rc(tid * 16 + i * 8192, R, C); const int Rb = Epi::PERM ? ((R & ~31) + perm32(R & 31)) : R;
        voffA[i] = GATHER ? (unsigned)(C * 2) : (unsigned)(R * ROWB + C * 2); voffB[i] = (unsigned)(Rb * ROWB + C * 2); rowA[i] = R; }
    constexpr size_t kstep = (size_t)(BK * 2);
    constexpr size_t hstep = (size_t)HALF * ROWB;
    const unsigned ldsw = (unsigned)wid * 1024u;
    const int aoff = lds_byte(wr * 64 + fr, fq * 8), boff = lds_byte(wc * 32 + fr, fq * 8);
    const LAS unsigned* rowtab = (const LAS unsigned*)(lds + (TAB_ROWOFF - 0));
#define PG8_SA(b, h) (((b) * 2 + (h)) * HTB)
#define PG8_SB(b, h) ((4 + (b) * 2 + (h)) * HTB)
#define PG8_GLDS(src, bufoff, i) __builtin_amdgcn_global_load_lds((const unsigned*)(src), (LAS unsigned*)(lds + (bufoff) + ldsw + (i) * 8192), 16, 0, 0)
#define PG8_STAGE_B(bufoff, gbase) do { PG8_GLDS((const char*)(gbase) + voffB[0], bufoff, 0); PG8_GLDS((const char*)(gbase) + voffB[1], bufoff, 1); } while (0)
#define PG8_STAGE_A(bufoff, gbase, h, g0, g1) do { if constexpr (GATHER) { PG8_GLDS((const char*)(gbase) + (g0) + voffA[0], bufoff, 0); PG8_GLDS((const char*)(gbase) + (g1) + voffA[1], bufoff, 1); } \
        else { PG8_GLDS((const char*)(gbase) + (h) * hstep + voffA[0], bufoff, 0); PG8_GLDS((const char*)(gbase) + (h) * hstep + voffA[1], bufoff, 1); } } while (0)
#define PG8_LDA(dst, b, h) do { _Pragma("unroll") for (int m = 0; m < 4; ++m) _Pragma("unroll") for (int k = 0; k < 2; ++k) dst[m][k] = *(const LAS bf16x8*)(lds + PG8_SA(b, h) + aoff + m * 2048 + k * 1024); } while (0)
#define PG8_LDB(dst, b, h) do { _Pragma("unroll") for (int n = 0; n < 2; ++n) _Pragma("unroll") for (int k = 0; k < 2; ++k) dst[n][k] = *(const LAS bf16x8*)(lds + PG8_SB(b, h) + boff + n * 2048 + k * 1024); } while (0)
#define PG8_MMA(ai, bj, At, Bt) do { __builtin_amdgcn_s_setprio(1); _Pragma("unroll") for (int m = 0; m < 4; ++m) _Pragma("unroll") for (int n = 0; n < 2; ++n) _Pragma("unroll") for (int k = 0; k < 2; ++k) { \
        if constexpr (I8) acc[ai][bj][m][n] = __builtin_amdgcn_mfma_i32_16x16x64_i8(__builtin_bit_cast(i32x4, Bt[n][k]), __builtin_bit_cast(i32x4, At[m][k]), acc[ai][bj][m][n], 0, 0, 0); \
        else acc[ai][bj][m][n] = __builtin_amdgcn_mfma_f32_16x16x32_bf16(Bt[n][k], At[m][k], acc[ai][bj][m][n], 0, 0, 0); } __builtin_amdgcn_s_setprio(0); } while (0)
#define PG8_WAIT_V(n) asm volatile("s_waitcnt vmcnt(" #n ")" ::: "memory")
#define PG8_WAIT_L(n) asm volatile("s_waitcnt lgkmcnt(" #n ")" ::: "memory")
#define PG8_BAR __builtin_amdgcn_s_barrier()
#define PG8_SCHED __builtin_amdgcn_sched_barrier(0)
    Unit cur, nxt; int ui = 0;
    if (!S.next(0, cur)) return;
    float pre_a = 0.f, pre_b = 0.f;
#define PG8_PRE(U) do { if constexpr (Epi::PRE) { if (tid < 256) { const float* pa_; const float* pb_; E.pre_addr(U, tid, pa_, pb_); pre_a = *pa_; pre_b = *pb_; } } } while (0)
    PG8_PRE(cur);
    acc_t acc[2][2][4][2];
#pragma unroll
    for (int a = 0; a < 2; ++a)
#pragma unroll
        for (int b = 0; b < 2; ++b)
#pragma unroll
            for (int m = 0; m < 4; ++m)
#pragma unroll
                for (int n = 0; n < 2; ++n) acc[a][b][m][n] = (acc_t){0, 0, 0, 0};
    bf16x8 At[4][2], B0[2][2], B1[2][2];
    const char* cA = cur.a; const char* cB = cur.b;
    unsigned g00 = 0, g01 = 0, g10 = 0, g11 = 0;
    if constexpr (GATHER) { const LAS unsigned* rt = rowtab + cur.slot * 256; g00 = rt[rowA[0]]; g01 = rt[rowA[1]]; g10 = rt[128 + rowA[0]]; g11 = rt[128 + rowA[1]]; }
    PG8_STAGE_B(PG8_SB(0, 0), cB); PG8_STAGE_B(PG8_SB(0, 1), cB + hstep); PG8_STAGE_A(PG8_SA(0, 0), cA, 0, g00, g01); PG8_STAGE_A(PG8_SA(0, 1), cA, 1, g10, g11);
    if (wr == 1) PG8_BAR;
    PG8_WAIT_V(2); PG8_BAR;
    PG8_STAGE_B(PG8_SB(1, 0), cB + kstep); PG8_STAGE_A(PG8_SA(1, 0), cA + kstep, 0, g00, g01); PG8_STAGE_B(PG8_SB(1, 1), cB + hstep + kstep);
    PG8_WAIT_V(6); PG8_BAR;
    for (;;) {
        const bool has_next = S.next(ui + 1, nxt);
        const char* nA = has_next ? nxt.a : cA; const char* nB = has_next ? nxt.b : cB;
        for (int t = 0; t < nt; t += 2) {
            const bool last = (t == nt - 2);
            const char* a1 = cA + (size_t)(t + 1) * kstep;
            const char* a2 = last ? nA : cA + (size_t)(t + 2) * kstep; const char* b2 = last ? nB : cB + (size_t)(t + 2) * kstep;
            const char* a3 = a2 + kstep; const char* b3 = b2 + kstep;
            unsigned n00 = g00, n01 = g01, n10 = g10, n11 = g11;
            if constexpr (GATHER) { if (last && has_next) { const LAS unsigned* rt = rowtab + nxt.slot * 256; n00 = rt[rowA[0]]; n01 = rt[rowA[1]]; n10 = rt[128 + rowA[0]]; n11 = rt[128 + rowA[1]]; } }
            PG8_LDB(B0, 0, 0); PG8_LDB(B1, 0, 1); PG8_SCHED; PG8_LDA(At, 0, 0); PG8_STAGE_A(PG8_SA(1, 1), a1, 1, g10, g11);
            PG8_WAIT_V(8); PG8_WAIT_L(0); PG8_BAR; PG8_MMA(0, 0, At, B0); PG8_MMA(0, 1, At, B1); PG8_BAR; PG8_SCHED;
            PG8_LDA(At, 0, 1); PG8_STAGE_B(PG8_SB(0, 0), b2); PG8_STAGE_B(PG8_SB(0, 1), b2 + hstep); PG8_STAGE_A(PG8_SA(0, 0), a2, 0, n00, n01);
            PG8_WAIT_V(8); PG8_WAIT_L(0); PG8_BAR; PG8_MMA(1, 0, At, B0); PG8_MMA(1, 1, At, B1); PG8_BAR; PG8_SCHED;
            PG8_LDB(B0, 1, 0); PG8_LDB(B1, 1, 1); PG8_SCHED; PG8_LDA(At, 1, 0); PG8_STAGE_A(PG8_SA(0, 1), a2, 1, n10, n11);
            PG8_WAIT_V(8); PG8_WAIT_L(0); PG8_BAR; PG8_MMA(0, 0, At, B0); PG8_MMA(0, 1, At, B1); PG8_BAR; PG8_SCHED;
            PG8_LDA(At, 1, 1); PG8_STAGE_B(PG8_SB(1, 0), b3); PG8_STAGE_B(PG8_SB(1, 1), b3 + hstep); PG8_STAGE_A(PG8_SA(1, 0), a3, 0, n00, n01);
            PG8_WAIT_V(8); PG8_WAIT_L(0); PG8_BAR; PG8_MMA(1, 0, At, B0); PG8_MMA(1, 1, At, B1); PG8_BAR; PG8_SCHED;
            if constexpr (GATHER) { if (last) { g00 = n00; g01 = n01; g10 = n10; g11 = n11; } }
        }
        if constexpr (ALIGN_EPI) { if (wr == 0) PG8_BAR; }
        { int tz = threadIdx.x; asm volatile("" : "+v"(tz));
          if constexpr (Epi::PRE) { LAS float* pt = (LAS float*)(lds + PRE_OFF); if (tz < 256) { pt[tz] = pre_a; pt[256 + tz] = pre_b; }
              asm volatile("s_waitcnt lgkmcnt(0)" ::: "memory"); __builtin_amdgcn_s_barrier(); asm volatile("" ::: "memory"); }
          const int ew = tz >> 6, el = tz & 63; E(acc, cur, ew >> 2, ew & 3, el & 15, el >> 4, lds); }
        if (!has_next) break;
        PG8_PRE(nxt);
#pragma unroll
        for (int a = 0; a < 2; ++a)
#pragma unroll
            for (int b = 0; b < 2; ++b)
#pragma unroll
                for (int m = 0; m < 4; ++m)
#pragma unroll
                    for (int n = 0; n < 2; ++n) acc[a][b][m][n] = (acc_t){0, 0, 0, 0};
        cur = nxt; cA = nA; cB = nB; ++ui;
        if constexpr (ALIGN_EPI) { if (wr == 1) PG8_BAR; }
    }
    PG8_WAIT_V(0);
    if constexpr (!ALIGN_EPI) { if (wr == 0) PG8_BAR; }
    PG8_BAR;
#undef PG8_SA
#undef PG8_SB
#undef PG8_GLDS
#undef PG8_STAGE_A
#undef PG8_STAGE_B
#undef PG8_LDA
#undef PG8_LDB
#undef PG8_MMA
#undef PG8_WAIT_V
#undef PG8_WAIT_L
#undef PG8_BAR
#undef PG8_SCHED
#undef PG8_PRE
}
}

struct Args { const float* in[26]; float* out; unsigned char* ws; int ph_lo, ph_hi; };
enum { I_X = 0, I_C, I_CTX, I_CCTX, I_WADA, I_BADA, I_GPRE1, I_GPOST1, I_GPRE2, I_GPOST2, I_WIN, I_QNORM, I_KNORM, I_GMLN, I_WS, I_BS, I_WBA, I_WBG, I_WO, I_WRG, I_BRG, I_WRE, I_BRE, I_WGATE, I_WUP, I_WDOWN };

struct Ctx {
    LAS unsigned char* lds; unsigned char* ws; unsigned* ctl;
    int tid, lane, wave, G, bx, vcu;
};

__device__ __forceinline__ void item_load(const float* W, int N, int k0, int n0, int lane, float (&tv)[32]) {
#pragma unroll
    for (int i = 0; i < 32; ++i) { const int kk = 2 * i + (lane >> 5); tv[i] = __builtin_nontemporal_load(&W[(size_t)(k0 + kk) * N + n0 + (lane & 31)]); }
}
__device__ __forceinline__ void item_store(const float (&tv)[32], int K, bf16_t* WT, int k0, int drow0, LAS float* scr, int lane) {
#pragma unroll
    for (int i = 0; i < 32; ++i) { const int kk = 2 * i + (lane >> 5); scr[kk * 33 + (lane & 31)] = tv[i]; }
    LDS_WAIT(); asm volatile("" ::: "memory");
    const int c = lane & 7;
#pragma unroll
    for (int j = 0; j < 4; ++j) { const int n = (lane >> 3) + 8 * j; const LAS float* s = scr + (8 * c) * 33 + n;
        u32x4 o; o.x = cvt_pk_bf16(s[0 * 33], s[1 * 33]); o.y = cvt_pk_bf16(s[2 * 33], s[3 * 33]); o.z = cvt_pk_bf16(s[4 * 33], s[5 * 33]); o.w = cvt_pk_bf16(s[6 * 33], s[7 * 33]);
        *(u32x4*)(WT + (size_t)(drow0 + n) * K + k0 + 8 * c) = o; }
    LDS_WAIT(); asm volatile("" ::: "memory");
}
constexpr int IT_WBA = 16 * 64, IT_WO = 32 * 64, IT_DN = 16 * 64;
constexpr int CHUNK_ITEMS = 8, N_CHUNKS_SMALL = (2 * IT_WBA) / CHUNK_ITEMS, N_CHUNKS_DN = NEXP * IT_DN / CHUNK_ITEMS;
constexpr int NSTRIPS_IN = 240, NSTRIPS_GU = NEXP * 64, NSTRIPS_DN = NEXP * 64, NSTRIPS_WO = 64, NSTRIPS_BR = 128;

__device__ __forceinline__ int strip_rowmap(int i, int mode) { return mode ? (32 * (i >> 4) + 8 * ((i >> 2) & 3) + 4 * (mode - 1) + (i & 3)) : i; }
template <int NH> __device__ __forceinline__ void strip_load_half(const Ctx& F, const float* src, int N, int h, f32x4 (&v)[16]) {
    const int c4 = F.lane & 7, rs = F.lane >> 3;
    const GAS float* p = (const GAS float*)(src + (size_t)(h * (64 * NH) + F.wave * (8 * NH) + rs) * N + c4 * 4); const size_t step = (size_t)8 * N;
#pragma unroll
    for (int i = 0; i < NH; ++i) { v[i] = __builtin_nontemporal_load((const GAS f32x4*)p); p += step; asm volatile("" : "+v"(p)); }
}
constexpr int STRIP_TAB = LDS_TAB + 2048;
template <int NH> __device__ __forceinline__ void strip_phase1_half(const Ctx& F, const f32x4 (&v)[16], int h, float (&cm)[4]) {
    const int c4 = F.lane & 7, rs = F.lane >> 3;
    const int k0 = h * (64 * NH) + F.wave * (8 * NH);
    LAS unsigned char* base = F.lds + (k0 + rs) * 64 + (k0 >> 4) * 8 + c4 * 8;
#pragma unroll
    for (int i = 0; i < NH; ++i) {
        cm[0] = fmaxf(cm[0], fabsf(v[i].x)); cm[1] = fmaxf(cm[1], fabsf(v[i].y)); cm[2] = fmaxf(cm[2], fabsf(v[i].z)); cm[3] = fmaxf(cm[3], fabsf(v[i].w));
        *(LAS u32x2*)(base + i * 512 + (i >> 1) * 8) = (u32x2){cvt_pk_bf16(v[i].x, v[i].y), cvt_pk_bf16(v[i].z, v[i].w)}; }
}
__device__ __forceinline__ void strip_phase1_finish(const Ctx& F, float (&cm)[4], float* sc, int mode, unsigned nx) {
    LAS float* cmtab = (LAS float*)(F.lds + STRIP_TAB); LAS float* sctab = cmtab + 256;
    const int c4 = F.lane & 7, rs = F.lane >> 3;
#pragma unroll
    for (int e = 0; e < 4; ++e) { cm[e] = fmaxf(cm[e], dppf<0x128>(cm[e])); cm[e] = pmax32(pmax16(cm[e])); }
    if (rs == 0) {
#pragma unroll
        for (int e = 0; e < 4; ++e) cmtab[F.wave * 32 + c4 * 4 + e] = cm[e]; }
    if (F.tid == 0) ((LAS unsigned*)(F.lds + LDS_MISC))[0] = nx;
    __syncthreads();
    if (F.tid < 32) { float m = 1e-30f;
#pragma unroll
        for (int w = 0; w < 8; ++w) m = fmaxf(m, cmtab[w * 32 + F.tid]);
        sctab[F.tid] = 127.0f / m; sc[strip_rowmap(F.tid, mode)] = m * (1.0f / 127.0f); }
    __syncthreads();
}
template <int NI> __device__ __forceinline__ void strip_phase2(const Ctx& F, signed char* dst, int mode) {
    const LAS float* sctab = (const LAS float*)(F.lds + STRIP_TAB) + 256;
    constexpr int KC = 4 * NI, K = 64 * NI;
#pragma unroll 1
    for (int i = 0; i < KC / 64; ++i) { const int bb = F.tid + 512 * i, kc = bb & (KC - 1), cg = bb / KC;
        const f32x4 inv = *(const LAS f32x4*)(sctab + cg * 4);
        const LAS unsigned char* rp = F.lds + kc * (1024 + 8) + cg * 8;
        u32x4 o[4];
        u32x2 w[2][4];
#pragma unroll
        for (int jj = 0; jj < 4; ++jj) w[0][jj] = *(const LAS u32x2*)(rp + jj * 64);
#pragma unroll
        for (int d = 0; d < 4; ++d) { unsigned t[4][4];
            if (d < 3) {
#pragma unroll
                for (int jj = 0; jj < 4; ++jj) w[(d + 1) & 1][jj] = *(const LAS u32x2*)(rp + ((d + 1) * 4 + jj) * 64); }
            __builtin_amdgcn_sched_barrier(0);
#pragma unroll
            for (int jj = 0; jj < 4; ++jj) { const u32x2 ww = w[d & 1][jj];
                t[0][jj] = __float_as_uint(fmaf(bf_lo(ww.x), inv.x, 12582912.0f)); t[1][jj] = __float_as_uint(fmaf(bf_hi(ww.x), inv.y, 12582912.0f));
                t[2][jj] = __float_as_uint(fmaf(bf_lo(ww.y), inv.z, 12582912.0f)); t[3][jj] = __float_as_uint(fmaf(bf_hi(ww.y), inv.w, 12582912.0f)); }
#pragma unroll
            for (int e = 0; e < 4; ++e) o[e][d] = __builtin_amdgcn_perm(t[e][1], t[e][0], 0x0c0c0400u) | __builtin_amdgcn_perm(t[e][3], t[e][2], 0x04000c0cu);
            __builtin_amdgcn_sched_barrier(0); }
#pragma unroll
        for (int e = 0; e < 4; ++e) __builtin_nontemporal_store(o[e], (u32x4*)(dst + (size_t)strip_rowmap(cg * 4 + e, mode) * K + kc * 16)); }
    __syncthreads();
}
__device__ __forceinline__ void strip_decode(const Ctx& F, const Args& A, int sid, int kind, const float*& src, int& N, signed char*& dst, float*& sc, int& mode) {
    mode = 0;
    if (kind == 0) { const int n0 = sid * 32, pn = n0 >> 8; int base = n0;
        if (pn == 0 || (pn >= 2 && pn < 6)) { const int hc = n0 & 127; mode = 1 + ((hc >> 5) & 1); base = (n0 & ~127) + 64 * (hc >> 6); }
        src = A.in[I_WIN] + n0; N = INW; dst = (signed char*)(F.ws + WS_WIN) + (size_t)base * 2048; sc = (float*)(F.ws + WS_SBIN) + base; }
    else if (kind == 1) { const int e = sid >> 6, q = sid & 63, up = q >> 5, n0 = (q & 31) * 32, drow0 = (n0 >> 7) * 256 + (n0 & 127) + up * 128;
        src = (up ? A.in[I_WUP] : A.in[I_WGATE]) + (size_t)e * 2048 * 1024 + n0; N = 1024; dst = (signed char*)(F.ws + WS_WGU) + (size_t)e * 2048 * 2048 + (size_t)drow0 * 2048; sc = (float*)(F.ws + WS_SBGU) + e * 2048 + drow0; }
    else if (kind == 4) { const int g = sid >> 6, n0 = (sid & 63) * 32;
        src = (g ? A.in[I_WBG] : A.in[I_WBA]) + n0; N = 2048; dst = (signed char*)(F.ws + (g ? WS_WBG : WS_WBA)) + (size_t)n0 * 1024; sc = (float*)(F.ws + (g ? WS_SBBG : WS_SBBA)) + n0; }
    else if (kind == 3) { const int n0 = sid * 32; src = A.in[I_WO] + n0; N = 2048; dst = (signed char*)(F.ws + WS_WO) + (size_t)n0 * 2048; sc = (float*)(F.ws + WS_SBWO) + n0; }
    else { const int e = sid >> 6, n0 = (sid & 63) * 32;
        src = A.in[I_WDOWN] + (size_t)e * 1024 * 2048 + n0; N = 2048; dst = (signed char*)(F.ws + WS_WDN) + (size_t)e * 2048 * 1024 + (size_t)n0 * 1024; sc = (float*)(F.ws + WS_SBDN) + e * 2048 + n0; }
}

__device__ __forceinline__ int wg_grab(const Ctx& F, unsigned* counter) {
    LAS unsigned* bw = (LAS unsigned*)(F.lds + LDS_MISC);
    if (F.tid == 0) bw[0] = __hip_atomic_fetch_add(counter, 1u, RLX_AGENT);
    __syncthreads();
    const int v = __builtin_amdgcn_readfirstlane((int)bw[0]);
    __syncthreads();
    return v;
}
template <int KIND> __device__ __forceinline__ void convert_strips(const Ctx& F, const Args& A, unsigned* counter) {
    constexpr int NS = KIND == 0 ? NSTRIPS_IN : (KIND == 1 ? NSTRIPS_GU : (KIND == 2 ? NSTRIPS_DN : (KIND == 3 ? NSTRIPS_WO : NSTRIPS_BR))), NH = (KIND == 2 || KIND == 4) ? 8 : 16;
    int sid = wg_grab(F, counter); if (sid >= NS) return;
    int nsid = wg_grab(F, counter);
    const float* src; int N; signed char* dst; float* sc; int mode;
    strip_decode(F, A, sid, KIND, src, N, dst, sc, mode);
    f32x4 va[16], vb[16]; strip_load_half<NH>(F, src, N, 0, va); strip_load_half<NH>(F, src, N, 1, vb);
    unsigned nx = 0; if (F.tid == 0) nx = __hip_atomic_fetch_add(counter, 1u, RLX_AGENT);
    float cm[4];
    for (;;) {
        signed char* cdst = dst; float* csc = sc; const int cmode = mode;
        cm[0] = cm[1] = cm[2] = cm[3] = 0.f;
        strip_phase1_half<NH>(F, va, 0, cm);
        if (nsid >= NS) break;
        strip_decode(F, A, nsid, KIND, src, N, dst, sc, mode); strip_load_half<NH>(F, src, N, 0, va);
        strip_phase1_half<NH>(F, vb, 1, cm);
        strip_load_half<NH>(F, src, N, 1, vb);
        strip_phase1_finish(F, cm, csc, cmode, nx);
        nsid = __builtin_amdgcn_readfirstlane((int)((const LAS unsigned*)(F.lds + LDS_MISC))[0]);
        if (F.tid == 0) nx = __hip_atomic_fetch_add(counter, 1u, RLX_AGENT);
        strip_phase2<2 * NH>(F, cdst, cmode);
    }
    strip_phase1_half<NH>(F, vb, 1, cm);
    strip_phase1_finish(F, cm, sc, mode, nx);
    strip_phase2<2 * NH>(F, dst, mode);
}
__device__ __forceinline__ void item_decode(const Ctx& F, const Args& A, int r, bool moe, const float*& W, bf16_t*& WT, int& K, int& N, int& k0, int& n0) {
    if (moe) { const int e = r / IT_DN; r -= e * IT_DN; W = A.in[I_WDOWN] + (size_t)e * 1024 * 2048; WT = (bf16_t*)(F.ws + WS_WDN) + (size_t)e * 2048 * 1024; K = 1024; N = 2048; }
    else if (r < IT_WBA) { W = A.in[I_WBA]; WT = (bf16_t*)(F.ws + WS_WBA); K = 1024; N = 2048; }
    else { r -= IT_WBA; W = A.in[I_WBG]; WT = (bf16_t*)(F.ws + WS_WBG); K = 1024; N = 2048; }
    const int nblk = N >> 5, kb = r / nblk, nb = r - kb * nblk; k0 = kb * 64; n0 = nb * 32;
}
__device__ __forceinline__ unsigned wave_grab(const Ctx& F, unsigned* counter) {
    unsigned ch = 0; if (F.lane == 0) ch = __hip_atomic_fetch_add(counter, 1u, RLX_AGENT);
    return (unsigned)__builtin_amdgcn_readfirstlane((int)ch);
}
__device__ __forceinline__ void convert_items(const Ctx& F, const Args& A, unsigned* counter, bool moe) {
    LAS float* scr = (LAS float*)(F.lds + F.wave * 16384);
    const unsigned NC = (unsigned)(moe ? N_CHUNKS_DN : N_CHUNKS_SMALL);
    for (;;) {
        const unsigned ch = wave_grab(F, counter); if (ch >= NC) break;
        for (int q = 0; q < CHUNK_ITEMS; q += 2) {
            const float* W0; bf16_t* WT0; int K0, N0, k00, n00; const float* W1; bf16_t* WT1; int K1, N1, k01, n01;
            item_decode(F, A, (int)ch * CHUNK_ITEMS + q, moe, W0, WT0, K0, N0, k00, n00);
            item_decode(F, A, (int)ch * CHUNK_ITEMS + q + 1, moe, W1, WT1, K1, N1, k01, n01);
            float ta[32], tb[32]; item_load(W0, N0, k00, n00, F.lane, ta); item_load(W1, N1, k01, n01, F.lane, tb);
            item_store(ta, K0, WT0, k00, n00, scr, F.lane);
            item_store(tb, K1, WT1, k01, n01, scr, F.lane);
        }
    }
}

__device__ __forceinline__ void p0_prologue(const Ctx& F, const Args& A, int rep) {
    { u32x4* xz = (u32x4*)(F.ws + WS_XCH); constexpr int NZ = (int)((WS_XCH_END - WS_XCH) / 16);
      for (int i = F.bx * NTHR + F.tid; i < NZ; i += F.G * NTHR) xz[i] = (u32x4){0u, 0u, 0u, 0u}; }
    if (F.bx < 192) {
        const int cg = F.bx % 48, kq = F.bx / 48;
        LAS float* sc = (LAS float*)F.lds;
        LAS float* red = (LAS float*)(F.lds + 32768);
        for (int idx = F.tid; idx < 9 * 512; idx += NTHR) { const int b = idx >> 9, kk = idx & 511; const float cv = (b < 8) ? A.in[I_C][b * DM + kq * 512 + kk] : A.in[I_CCTX][kq * 512 + kk]; sc[idx] = siluf_(cv); }
        __syncthreads();
        const float* wp = A.in[I_WADA] + (size_t)(kq * 512 + F.wave * 64) * NMOD + cg * 256 + F.lane * 4;
        f32x4 acc[9];
#pragma unroll
        for (int b = 0; b < 9; ++b) acc[b] = (f32x4){0.f, 0.f, 0.f, 0.f};
#pragma unroll 8
        for (int kk = 0; kk < 64; ++kk) { const f32x4 wv = __builtin_nontemporal_load((const f32x4*)(wp + (size_t)kk * NMOD));
#pragma unroll
            for (int b = 0; b < 9; ++b) { const float s = sc[b * 512 + F.wave * 64 + kk]; acc[b] += wv * s; } }
#pragma unroll
        for (int b = 0; b < 9; ++b) *(LAS f32x4*)(red + ((F.wave * 9 + b) * 256 + F.lane * 4)) = acc[b];
        __syncthreads();
        float* modp = (float*)(F.ws + WS_MODP) + (size_t)kq * 9 * NMOD;
        for (int idx = F.tid; idx < 9 * 256; idx += NTHR) { float s = 0.f;
#pragma unroll
            for (int w = 0; w < 8; ++w) s += red[w * 9 * 256 + idx];
            modp[(size_t)(idx >> 8) * NMOD + cg * 256 + (idx & 255)] = s; }
        __syncthreads();
    } else {
        const int gid = (F.bx - 192) * NTHR + F.tid, gstride = (F.G - 192) * NTHR;
        for (int it = gid; it < 2048 + 24576 + 16384; it += gstride) {
            if (it < 2048) { const int pos = it >> 5, i = it & 31;
                const float inv = fexp2(-(float)(2 * i) * (13.287712379549449f / 64.0f));
                float rev = (float)pos * inv * 0.15915494309189535f; rev -= floorf(rev);
                f32x2 cs; cs.x = __builtin_amdgcn_cosf(rev); cs.y = __builtin_amdgcn_sinf(rev);
                ((f32x2*)(F.ws + WS_ROPE))[it] = cs;
            } else if (it < 2048 + 24576) { const int r = it - 2048, ln = r & 63, hl = (r >> 6) & 1, q = r >> 7, ntile = q % 3, ks = q / 3;
                unsigned w[4];
#pragma unroll
                for (int jj = 0; jj < 4; ++jj) { float v[2];
#pragma unroll
                    for (int e = 0; e < 2; ++e) { const int k = ks * 32 + 8 * (ln >> 4) + 2 * jj + e, n = ln & 15; float wv;
                        if (ntile < 2) wv = A.in[I_WRE][(size_t)k * 32 + ntile * 16 + n]; else wv = (n < 4) ? A.in[I_WRG][(size_t)k * 4 + n] : 0.f;
                        const float hi = bf_lo(cvt_pk_bf16(wv, 0.f)); v[e] = hl ? (wv - hi) : wv; }
                    w[jj] = cvt_pk_bf16(v[0], v[1]); }
                ((u32x4*)(F.ws + WS_WRF))[r] = (u32x4){w[0], w[1], w[2], w[3]};
            } else { const int r = it - 2048 - 24576; const f32x4 a = ((const f32x4*)A.in[I_WS])[2 * r], b = ((const f32x4*)A.in[I_WS])[2 * r + 1];
                ((u32x4*)(F.ws + WS_WSB))[r] = (u32x4){cvt_pk_bf16(a.x, a.y), cvt_pk_bf16(a.z, a.w), cvt_pk_bf16(b.x, b.y), cvt_pk_bf16(b.z, b.w)}; }
        }
    }
    __syncthreads();
    convert_strips<0>(F, A, F.ctl + CW_STRIP + 64 * rep);
    convert_strips<3>(F, A, F.ctl + CW_STRIP3);
    convert_strips<4>(F, A, F.ctl + CW_WORK + 64 * rep);
}

__device__ __forceinline__ f32x4 mod4(const Ctx& F, const Args& A, int bb, int j, int col) {
    const float* mp = (const float*)(F.ws + WS_MODP) + (size_t)bb * NMOD + j * DM + col;
    const f32x4 t0 = *(const f32x4*)(A.in[I_BADA] + j * DM + col), t1 = *(const f32x4*)(mp), t2 = *(const f32x4*)(mp + (size_t)9 * NMOD), t3 = *(const f32x4*)(mp + (size_t)18 * NMOD), t4 = *(const f32x4*)(mp + (size_t)27 * NMOD);
    return ((t0 + t1) + (t2 + t3)) + t4;
}
__device__ __forceinline__ void p1_mod_vectors(const Ctx& F, const Args& A, int bb, f32x4 (&a1)[8], f32x4 (&b1)[8]) {
    const float* mp = (const float*)(F.ws + WS_MODP) + (size_t)bb * NMOD + F.lane * 4;
#pragma unroll
    for (int h = 0; h < 4; ++h) {
        f32x4 ts[2][5], th[2][5], gp[2];
#pragma unroll
        for (int jj = 0; jj < 2; ++jj) { const int co = 256 * (h * 2 + jj);
            gp[jj] = *(const f32x4*)(A.in[I_GPRE1] + F.lane * 4 + co);
            th[jj][0] = *(const f32x4*)(A.in[I_BADA] + F.lane * 4 + co); ts[jj][0] = *(const f32x4*)(A.in[I_BADA] + DM + F.lane * 4 + co);
#pragma unroll
            for (int q = 0; q < 4; ++q) { th[jj][q + 1] = *(const f32x4*)(mp + (size_t)q * 9 * NMOD + co); ts[jj][q + 1] = *(const f32x4*)(mp + (size_t)q * 9 * NMOD + DM + co); } }
#pragma unroll
        for (int jj = 0; jj < 2; ++jj) { const int j = h * 2 + jj;
            b1[j] = ((th[jj][0] + th[jj][1]) + (th[jj][2] + th[jj][3])) + th[jj][4];
            a1[j] = gp[jj] * ((((ts[jj][0] + ts[jj][1]) + (ts[jj][2] + ts[jj][3])) + ts[jj][4]) + 1.0f); }
    }
}

__device__ __forceinline__ void modf_finalize(const Ctx& F, const Args& A) {
    { const int gid = F.bx * NTHR + F.tid;
      if (gid < 8 * 4 * 512) { const int col = (gid & 511) * 4, v = (gid >> 9) & 3, b = gid >> 11; f32x4 o;
          if (v == 0) o = mod4(F, A, b, 2, col) * *(const f32x4*)(A.in[I_GPOST1] + col);
          else if (v == 1) o = *(const f32x4*)(A.in[I_GPRE2] + col) * (mod4(F, A, b, 4, col) + 1.0f);
          else if (v == 2) o = mod4(F, A, b, 3, col);
          else o = mod4(F, A, b, 5, col) * *(const f32x4*)(A.in[I_GPOST2] + col);
          *(f32x4*)((float*)(F.ws + WS_MODF) + (size_t)(b * 4 + v) * DM + col) = o; } }
}

__device__ __forceinline__ void p1_rows(const Ctx& F, const Args& A) {
    const int gw = F.vcu * NWAVES + F.wave, NGW = F.G * NWAVES, RPW = (NROW + NGW - 1) / NGW;
    const int wrow0 = F.vcu * NWAVES * RPW, wrowl = (wrow0 + NWAVES * RPW - 1 < NROW) ? wrow0 + NWAVES * RPW - 1 : NROW - 1;
    const int bb0 = wrow0 < NTOK ? (wrow0 >> 11) : 8, bb1 = wrowl < NTOK ? (wrowl >> 11) : 8;
    const int scol = F.tid * 4;
    f32x4 sgp = *(const f32x4*)(A.in[I_GPRE1] + scol), sh0 = *(const f32x4*)(A.in[I_BADA] + scol), ss0 = *(const f32x4*)(A.in[I_BADA] + DM + scol);
    f32x4 shq[2][4], ssq[2][4];
#pragma unroll
    for (int z = 0; z < 2; ++z) { const float* smp = (const float*)(F.ws + WS_MODP) + (size_t)(z ? bb1 : bb0) * NMOD + scol;
#pragma unroll
        for (int q = 0; q < 4; ++q) { shq[z][q] = *(const f32x4*)(smp + (size_t)q * 9 * NMOD); ssq[z][q] = *(const f32x4*)(smp + (size_t)q * 9 * NMOD + DM); } }
    signed char* HX = (signed char*)(F.ws + WS_HX);
    const int rbeg = gw * RPW, rend = ((gw + 1) * RPW < NROW) ? (gw + 1) * RPW : NROW;
    f32x4 v[8], v1[8], v2[8], v3[8];
#define P1_LOAD(r_, dst) do { const int rq_ = (r_); const float* src_ = rq_ < NTOK ? A.in[I_X] + (size_t)rq_ * DM : A.in[I_CTX] + (size_t)(rq_ - NTOK) * DM; \
        _Pragma("unroll") for (int j = 0; j < 8; ++j) dst[j] = __builtin_nontemporal_load((const f32x4*)(src_ + F.lane * 4 + 256 * j)); } while (0)
    if (rbeg < rend) P1_LOAD(rbeg, v);
    if (rbeg + 1 < rend) P1_LOAD(rbeg + 1, v1);
    if (rbeg + 2 < rend) P1_LOAD(rbeg + 2, v2);
#pragma unroll
    for (int z = 0; z < 2; ++z) {
        *(LAS f32x4*)(F.lds + z * 32768 + 16384 + scol * 4) = ((sh0 + shq[z][0]) + (shq[z][1] + shq[z][2])) + shq[z][3];
        *(LAS f32x4*)(F.lds + z * 32768 + scol * 4) = sgp * ((((ss0 + ssq[z][0]) + (ssq[z][1] + ssq[z][2])) + ssq[z][3]) + 1.0f); }
    __syncthreads();
    for (int row = rbeg; row < rend; ++row) {
        if (row + 3 < rend) P1_LOAD(row + 3, v3);
        const int bb = row < NTOK ? (row >> 11) : 8;
        const LAS unsigned char* mv = F.lds + (bb == bb0 ? 0 : 32768) + F.lane * 16;
        float s = 0.f;
#pragma unroll
        for (int j = 0; j < 8; ++j) s += (v[j].x * v[j].x + v[j].y * v[j].y) + (v[j].z * v[j].z + v[j].w * v[j].w);
        s = wave_sum(s);
        const float rstd = 1.0f / sqrtf(s * (1.0f / DM) + EPS);
        if (row < NTOK && F.lane == 0) ((float*)(F.ws + WS_XSQ))[row] = s;
        float mx = 0.f;
#pragma unroll
        for (int j = 0; j < 8; ++j) { v[j] = v[j] * rstd * *(const LAS f32x4*)(mv + 1024 * j) + *(const LAS f32x4*)(mv + 16384 + 1024 * j); mx = fmaxf(fmaxf(mx, fmaxf(fabsf(v[j].x), fabsf(v[j].y))), fmaxf(fabsf(v[j].z), fabsf(v[j].w))); }
        mx = wave_max(mx);
        mx = fmaxf(mx, 1e-20f); const float inv = 127.0f / mx;
        if (F.lane == 0) ((float*)(F.ws + WS_SA))[row] = mx * (1.0f / 127.0f);
#pragma unroll
        for (int j = 0; j < 8; ++j) *(unsigned*)(HX + (size_t)row * DM + F.lane * 4 + 256 * j) = q8x4m(v[j], inv);
#pragma unroll
        for (int j = 0; j < 8; ++j) { v[j] = v1[j]; v1[j] = v2[j]; v2[j] = v3[j]; }
    }
#undef P1_LOAD
}

struct SchedInProj {
    const char* A; const char* B; int G, c;
    __device__ __forceinline__ bool next(int i, pg8::Unit& u) const {
        const int L = i * G + c; if (L >= 1936) return false;
        int pm, pn; if (L < 1920) pg8::static_map(L, 64, 30, pm, pn); else { const int k = L - 1920; pm = 64 + (k >> 1); pn = k & 1; }
        u.pm = pm; u.pn = pn; u.e = 0; u.slot = 0; u.a = A + (size_t)pm * (256 * 2048); u.b = B + (size_t)pn * (256 * 2048); return true;
    }
};
struct EpiInProj {
    static constexpr bool PERM = true, PRE = true;
    unsigned char* ws; const float* qnw; const float* knw;
    __device__ __forceinline__ void pre_addr(const pg8::Unit& u, int t, const float*& pa, const float*& pb) const { pa = (const float*)(ws + WS_SA) + u.pm * 256 + t; pb = (const float*)(ws + WS_SBIN) + u.pn * 256 + t; }
    __device__ __forceinline__ void qk_tile(const i32x4 (&acc)[2][2][4][2], const pg8::Unit& u, int wr, int wc, int fr, int fq, LAS unsigned char* lds) const {
        const bool isk = (u.pn == 0);
        LAS float* P = (LAS float*)(lds + LDS_TAB);
        const LAS float* sbp = (const LAS float*)(lds + PRE_OFF) + 256 + wc * 32 + 8 * fq; const LAS float* sap = (const LAS float*)(lds + PRE_OFF);
        f32x4 sb[2][2];
#pragma unroll
        for (int bj = 0; bj < 2; ++bj) { sb[bj][0] = *(const LAS f32x4*)(sbp + bj * 128); sb[bj][1] = *(const LAS f32x4*)(sbp + bj * 128 + 4); }
        float sa8[2][4];
#pragma unroll
        for (int ai = 0; ai < 2; ++ai)
#pragma unroll
            for (int m = 0; m < 4; ++m) sa8[ai][m] = sap[ai * 128 + wr * 64 + m * 16 + fr];
#pragma unroll
        for (int ai = 0; ai < 2; ++ai)
#pragma unroll
            for (int m = 0; m < 4; ++m) { const int r = ai * 128 + wr * 64 + m * 16 + fr; const float sa = sa8[ai][m];
#pragma unroll
                for (int bj = 0; bj < 2; ++bj) { float ss = 0.f;
#pragma unroll
                    for (int n = 0; n < 2; ++n)
#pragma unroll
                        for (int j = 0; j < 4; ++j) { const float v = (float)acc[ai][bj][m][n][j] * sa * sb[bj][n][j]; ss += v * v; }
                    ss = psum32(psum16(ss));
                    if (fq == 0) P[(r * 2 + bj) * 4 + wc] = ss; } }
        asm volatile("s_waitcnt lgkmcnt(0)" ::: "memory"); __builtin_amdgcn_s_barrier(); asm volatile("" ::: "memory");
        const int hc0 = (wc >> 1) * 64 + (wc & 1) * 16 + fq * 4;
        const float* nw = isk ? knw : qnw; const float qs = isk ? 1.0f : ATT_QSC;
        const f32x4 w0 = *(const f32x4*)(nw + hc0) * qs, w1 = *(const f32x4*)(nw + hc0 + 32) * qs;
        const f32x2* rope = (const f32x2*)(ws + WS_ROPE);
#pragma unroll
        for (int ai = 0; ai < 2; ++ai)
#pragma unroll
            for (int m = 0; m < 4; ++m) { const int r = ai * 128 + wr * 64 + m * 16 + fr, grow = u.pm * 256 + r; const float sa = sa8[ai][m];
                const bool isx = grow < NTOK; const int t = grow & 2047, pos = (wc >> 1) ? (t & 63) : (t >> 6);
                f32x2 cs[4];
#pragma unroll
                for (int j = 0; j < 4; ++j) cs[j] = isx ? rope[pos * 32 + (wc & 1) * 16 + fq * 4 + j] : (f32x2){1.f, 0.f};
                const int krow = isx ? ((grow >> 11) * LK + CTXL + t) : (((grow - NTOK) >> 8) * LK + ((grow - NTOK) & 255));
#pragma unroll
                for (int bj = 0; bj < 2; ++bj) { const f32x4 p4 = *(const LAS f32x4*)(P + (r * 2 + bj) * 4);
                    const float rstd = 1.0f / sqrtf(((p4.x + p4.y) + (p4.z + p4.w)) * (1.0f / HD) + EPS);
                    float o1[4], o2[4];
#pragma unroll
                    for (int j = 0; j < 4; ++j) { const float x1 = (float)acc[ai][bj][m][0][j] * sa * sb[bj][0][j] * rstd * w0[j], x2 = (float)acc[ai][bj][m][1][j] * sa * sb[bj][1][j] * rstd * w1[j];
                        o1[j] = x1 * cs[j].x - x2 * cs[j].y; o2[j] = x2 * cs[j].x + x1 * cs[j].y; }
                    bf16_t* dst = isk ? ((bf16_t*)(ws + WS_KN) + (size_t)krow * KVW + bj * HD + hc0) : ((bf16_t*)(ws + WS_Q) + (size_t)grow * QW + ((u.pn - 2) * 2 + bj) * HD + hc0);
                    *(u32x2*)dst = (u32x2){cvt_pk_bf16(o1[0], o1[1]), cvt_pk_bf16(o1[2], o1[3])};
                    *(u32x2*)(dst + 32) = (u32x2){cvt_pk_bf16(o2[0], o2[1]), cvt_pk_bf16(o2[2], o2[3])}; } }
    }
    __device__ __forceinline__ void operator()(const i32x4 (&acc)[2][2][4][2], const pg8::Unit& u, int wr, int wc, int fr, int fq, LAS unsigned char* lds) const {
        const int pn = u.pn; bf16_t* base; int ld, co, act;
        if (pn == 0 || (pn >= 2 && pn < 6)) { qk_tile(acc, u, wr, wc, fr, fq, lds); return; }
        if (pn == 0) { base = (bf16_t*)(ws + WS_KRAW); ld = 256; co = 0; act = 0; }
        else if (pn == 1) { base = (bf16_t*)(ws + WS_V); ld = 256; co = 0; act = 0; }
        else if (pn < 6) { base = (bf16_t*)(ws + WS_Q); ld = 1024; co = (pn - 2) * 256; act = 0; }
        else if (pn < 10) { base = (bf16_t*)(ws + WS_U); ld = 1024; co = (pn - 6) * 256; act = 1; }
        else if (pn < 14) { base = (bf16_t*)(ws + WS_VG); ld = 1024; co = (pn - 10) * 256; act = 1; }
        else if (pn < 22) { base = (bf16_t*)(ws + WS_GA); ld = 2048; co = (pn - 14) * 256; act = 2; }
        else { base = (bf16_t*)(ws + WS_GG); ld = 2048; co = (pn - 22) * 256; act = 2; }
        const int cw = co + wc * 32 + 8 * fq;
        const LAS float* sbp = (const LAS float*)(lds + PRE_OFF) + 256 + wc * 32 + 8 * fq; const LAS float* sap = (const LAS float*)(lds + PRE_OFF);
        f32x4 sb[2][2];
#pragma unroll
        for (int bj = 0; bj < 2; ++bj) { sb[bj][0] = *(const LAS f32x4*)(sbp + bj * 128); sb[bj][1] = *(const LAS f32x4*)(sbp + bj * 128 + 4); }
        float sa8[2][4];
#pragma unroll
        for (int ai = 0; ai < 2; ++ai)
#pragma unroll
            for (int m = 0; m < 4; ++m) sa8[ai][m] = sap[ai * 128 + wr * 64 + m * 16 + fr];
#pragma unroll
        for (int ai = 0; ai < 2; ++ai)
#pragma unroll
            for (int m = 0; m < 4; ++m) {
                const int row0 = u.pm * 256 + ai * 128 + wr * 64 + m * 16 + fr; int row = row0; const float sa = sa8[ai][m];
                if (pn == 1) row = (row < NTOK) ? ((row >> 11) * LK + CTXL + (row & 2047)) : (((row - NTOK) >> 8) * LK + ((row - NTOK) & 255));
                bf16_t* rowp = base + (size_t)row * ld + cw;
#pragma unroll
                for (int bj = 0; bj < 2; ++bj) { f32x4 v0, v1;
#pragma unroll
                    for (int j = 0; j < 4; ++j) { v0[j] = (float)acc[ai][bj][m][0][j] * sa * sb[bj][0][j]; v1[j] = (float)acc[ai][bj][m][1][j] * sa * sb[bj][1][j]; }
                    if (act == 2) {
#pragma unroll
                        for (int j = 0; j < 4; ++j) { v0[j] = sigmoidf_(v0[j]); v1[j] = sigmoidf_(v1[j]); }
                        __builtin_nontemporal_store((u32x2){q8x4m(v0, 255.0f), q8x4m(v1, 255.0f)}, (u32x2*)((unsigned char*)base + (size_t)row * ld + cw + bj * 128)); continue; }
                    if (act == 1) {
#pragma unroll
                        for (int j = 0; j < 4; ++j) { v0[j] = gelu_tanh(v0[j]); v1[j] = gelu_tanh(v1[j]); } }
                    u32x4 w; w.x = cvt_pk_bf16(v0[0], v0[1]); w.y = cvt_pk_bf16(v0[2], v0[3]); w.z = cvt_pk_bf16(v1[0], v1[1]); w.w = cvt_pk_bf16(v1[2], v1[3]);
                    if (act == 1) __builtin_nontemporal_store(w, (u32x4*)(rowp + bj * 128)); else *(u32x4*)(rowp + bj * 128) = w; } }
    }
};

namespace att {
constexpr int D = 128, NW = 8, QBLK = 32, KVBLK = 64;
constexpr float SCALE = 0.088388347648318440f, THR = 8.f, QSC = ATT_QSC, THR2 = THR * 1.4426950408889634f;
constexpr int LDQ = QW, LDK = KVW, LDO = QW;
constexpr size_t SHM_V = KVBLK * D * 2, SHM_K = KVBLK * D * 2, SHM_ATTN = 2 * SHM_V + 2 * SHM_K + NW * 64 * 4;
#define KSWZ(row, colB) ((row) * 256 + ((colB) ^ (((row) & 7) << 4)))
#define SBAR() __builtin_amdgcn_sched_barrier(0)
__device__ __forceinline__ int crow(int r, int hi) { return (r & 3) + 8 * (r >> 2) + 4 * hi; }
__device__ __forceinline__ void partialSM(f32x16& p0, f32x16& p1, float& m_reg, float& mn, float& alpha) {
  float pmax = p0[0]; for (int r = 1; r < 16; ++r) pmax = fmaxf(pmax, p0[r]); for (int r = 0; r < 16; ++r) pmax = fmaxf(pmax, p1[r]);
  { auto rr = __builtin_amdgcn_permlane32_swap(__float_as_uint(pmax), __float_as_uint(pmax), false, false);
    pmax = fmaxf(__uint_as_float(rr[0]), __uint_as_float(rr[1])); }
  mn = pmax; m_reg = pmax; alpha = 1.f;
  for (int r = 0; r < 16; ++r) p0[r] -= pmax; for (int r = 0; r < 16; ++r) p1[r] -= pmax;
  for (int r = 0; r < 16; ++r) p0[r] = __builtin_amdgcn_exp2f(p0[r]);
}
__device__ __forceinline__ void finishSM(f32x16& p0, f32x16& p1, float alpha, float& l_reg, bf16x8& pa0, bf16x8& pa1, bf16x8& pa2, bf16x8& pa3) {
  for (int r = 0; r < 16; ++r) p1[r] = __builtin_amdgcn_exp2f(p1[r]);
  float ps = 0; for (int r = 0; r < 16; ++r) ps += p0[r]; for (int r = 0; r < 16; ++r) ps += p1[r];
  { auto rr = __builtin_amdgcn_permlane32_swap(__float_as_uint(ps), __float_as_uint(ps), false, false);
    ps = __uint_as_float(rr[0]) + __uint_as_float(rr[1]); }
  l_reg = l_reg * alpha + ps;
#define PK4(P, BASE, OUT) do { unsigned a0 = cvt_pk_bf16(P[BASE + 0], P[BASE + 1]), a1 = cvt_pk_bf16(P[BASE + 2], P[BASE + 3]);   \
    unsigned b0 = cvt_pk_bf16(P[BASE + 4], P[BASE + 5]), b1 = cvt_pk_bf16(P[BASE + 6], P[BASE + 7]);                              \
    auto r0 = __builtin_amdgcn_permlane32_swap(a0, b0, false, false); auto r1 = __builtin_amdgcn_permlane32_swap(a1, b1, false, false); \
    u32x4 w = {r0[0], r1[0], r0[1], r1[1]}; OUT = *reinterpret_cast<bf16x8*>(&w); } while (0)
  PK4(p0, 0, pa0); PK4(p0, 8, pa1); PK4(p1, 0, pa2); PK4(p1, 8, pa3);
#undef PK4
}
__device__ __forceinline__ void qkt(f32x16& p0, f32x16& p1, const bf16_t* Ks, const bf16x8* qr, int r32, int hi, float acc0) {
  for (int r = 0; r < 16; ++r) { p0[r] = acc0; p1[r] = acc0; }
  for (int d0 = 0; d0 < 8; ++d0) { int cb = (d0 * 16 + hi * 8) * 2;
    bf16x8 b0 = *reinterpret_cast<const bf16x8*>((const char*)Ks + KSWZ(r32, cb));
    bf16x8 b1 = *reinterpret_cast<const bf16x8*>((const char*)Ks + KSWZ(32 + r32, cb));
    p0 = __builtin_amdgcn_mfma_f32_32x32x16_bf16(b0, qr[d0], p0, 0, 0, 0);
    p1 = __builtin_amdgcn_mfma_f32_32x32x16_bf16(b1, qr[d0], p1, 0, 0, 0); }
}
__device__ __forceinline__ int v_st(int k, int c) { const int kk = (k & ~0xC) | ((k & 4) << 1) | ((k & 8) >> 1); return ((kk >> 3) * 4 + (c >> 5)) * 512 + ((kk & 7) * 32 + (c & 31)) * 2; }
__device__ __forceinline__ int v_rd_base(int lane) { return ((lane & 3) << 3) | (((lane >> 2) & 3) << 6) | (((lane >> 4) & 1) << 5) | (((lane >> 5) & 1) << 8); }
constexpr int v_rd_off(int d0, int ks, int half) { return d0 * 512 + ks * 4096 + half * 2048; }
template <int OFF> __device__ __forceinline__ s16x4 tr_read(int vb) {
  s16x4 r; asm volatile("ds_read_b64_tr_b16 %0, %1 offset:%2" : "=&v"(r) : "v"(vb), "i"(OFF) : "memory"); return r;
}
template <int D0> __device__ __forceinline__ void pv_one(f32x16& od, int vb, bf16x8 pa0, bf16x8 pa1, bf16x8 pa2, bf16x8 pa3) {
  const s16x4 l0 = tr_read<v_rd_off(D0, 0, 0)>(vb), h0 = tr_read<v_rd_off(D0, 0, 1)>(vb), l1 = tr_read<v_rd_off(D0, 1, 0)>(vb), h1 = tr_read<v_rd_off(D0, 1, 1)>(vb);
  const s16x4 l2 = tr_read<v_rd_off(D0, 2, 0)>(vb), h2 = tr_read<v_rd_off(D0, 2, 1)>(vb), l3 = tr_read<v_rd_off(D0, 3, 0)>(vb), h3 = tr_read<v_rd_off(D0, 3, 1)>(vb);
  asm volatile("s_waitcnt lgkmcnt(0)" ::: "memory"); SBAR();
#define PK(L, H) (bf16x8){L[0], L[1], L[2], L[3], H[0], H[1], H[2], H[3]}
  od = __builtin_amdgcn_mfma_f32_32x32x16_bf16(pa0, PK(l0, h0), od, 0, 0, 0);
  od = __builtin_amdgcn_mfma_f32_32x32x16_bf16(pa1, PK(l1, h1), od, 0, 0, 0);
  od = __builtin_amdgcn_mfma_f32_32x32x16_bf16(pa2, PK(l2, h2), od, 0, 0, 0);
  od = __builtin_amdgcn_mfma_f32_32x32x16_bf16(pa3, PK(l3, h3), od, 0, 0, 0);
#undef PK
}
template <int D0> __device__ __forceinline__ void pv_reads(int vb, s16x4 (&v)[8]) {
  v[0] = tr_read<v_rd_off(D0, 0, 0)>(vb); v[1] = tr_read<v_rd_off(D0, 0, 1)>(vb); v[2] = tr_read<v_rd_off(D0, 1, 0)>(vb); v[3] = tr_read<v_rd_off(D0, 1, 1)>(vb);
  v[4] = tr_read<v_rd_off(D0, 2, 0)>(vb); v[5] = tr_read<v_rd_off(D0, 2, 1)>(vb); v[6] = tr_read<v_rd_off(D0, 3, 0)>(vb); v[7] = tr_read<v_rd_off(D0, 3, 1)>(vb);
}
__device__ __forceinline__ void pv_mma(f32x16& od, const s16x4 (&v)[8], bf16x8 pa0, bf16x8 pa1, bf16x8 pa2, bf16x8 pa3) {
  asm volatile("s_waitcnt lgkmcnt(0)" ::: "memory"); SBAR();
#define PK(L, H) (bf16x8){L[0], L[1], L[2], L[3], H[0], H[1], H[2], H[3]}
  od = __builtin_amdgcn_mfma_f32_32x32x16_bf16(pa0, PK(v[0], v[1]), od, 0, 0, 0);
  od = __builtin_amdgcn_mfma_f32_32x32x16_bf16(pa1, PK(v[2], v[3]), od, 0, 0, 0);
  od = __builtin_amdgcn_mfma_f32_32x32x16_bf16(pa2, PK(v[4], v[5]), od, 0, 0, 0);
  od = __builtin_amdgcn_mfma_f32_32x32x16_bf16(pa3, PK(v[6], v[7]), od, 0, 0, 0);
#undef PK
}
__device__ __forceinline__ void pv_sm(f32x16* o, int vb, bf16x8 pa0, bf16x8 pa1, bf16x8 pa2, bf16x8 pa3, f32x16& p0, f32x16& p1, float& m_reg, float& mn, float& alpha) {
  s16x4 v[8];
  pv_reads<0>(vb, v); SBAR();
  { float pmax = p0[0]; for (int r = 1; r < 16; ++r) pmax = fmaxf(pmax, p0[r]); for (int r = 0; r < 16; ++r) pmax = fmaxf(pmax, p1[r]);
    { auto rr = __builtin_amdgcn_permlane32_swap(__float_as_uint(pmax), __float_as_uint(pmax), false, false);
      pmax = fmaxf(__uint_as_float(rr[0]), __uint_as_float(rr[1])); }
    if (__builtin_expect(__all(pmax <= THR2), 1)) { mn = m_reg; alpha = 1.f; }
    else { const float d = fmaxf(pmax, 0.f); mn = m_reg + d; alpha = __builtin_amdgcn_exp2f(-d); m_reg = mn;
      for (int r = 0; r < 16; ++r) { p0[r] -= d; p1[r] -= d; } } }
  pv_mma(o[0], v, pa0, pa1, pa2, pa3);
  pv_reads<1>(vb, v); SBAR();
  for (int r = 0; r < 6; ++r) p0[r] = __builtin_amdgcn_exp2f(p0[r]);
  pv_mma(o[1], v, pa0, pa1, pa2, pa3);
  pv_reads<2>(vb, v); SBAR();
  for (int r = 6; r < 11; ++r) p0[r] = __builtin_amdgcn_exp2f(p0[r]);
  pv_mma(o[2], v, pa0, pa1, pa2, pa3);
  pv_reads<3>(vb, v); SBAR();
  for (int r = 11; r < 16; ++r) p0[r] = __builtin_amdgcn_exp2f(p0[r]);
  pv_mma(o[3], v, pa0, pa1, pa2, pa3);
}
__device__ __forceinline__ void pv_d0(f32x16* o, int vb, bf16x8 pa0, bf16x8 pa1, bf16x8 pa2, bf16x8 pa3) {
  pv_one<0>(o[0], vb, pa0, pa1, pa2, pa3); pv_one<1>(o[1], vb, pa0, pa1, pa2, pa3); pv_one<2>(o[2], vb, pa0, pa1, pa2, pa3); pv_one<3>(o[3], vb, pa0, pa1, pa2, pa3);
}
__device__ __forceinline__ void attn_dense_body(const bf16_t* __restrict__ Qb, const bf16_t* __restrict__ Kh, const bf16_t* __restrict__ Vh, bf16_t* __restrict__ Ob, int seq, char* lds) {
  const int tid = threadIdx.x, wid = tid >> 6, lane = tid & 63, r32 = lane & 31, hi = lane >> 5;
  bf16_t* V_lds = (bf16_t*)lds; bf16_t* K_lds = (bf16_t*)(lds + 2 * SHM_V);
  float* ws = (float*)(lds + 2 * SHM_V + 2 * SHM_K) + wid * 64; float* li_l = ws; float* al_l = ws + 32;
  float m_reg = -1e30f, l_reg = 0; f32x16 o[4] = {}; bf16x8 qr[8];
  const bf16_t* Qw = Qb + (long)(wid * QBLK + r32) * LDQ + hi * 8;
#pragma unroll
  for (int d0 = 0; d0 < 8; ++d0) qr[d0] = *reinterpret_cast<const bf16x8*>(Qw + d0 * 16);
  const int sr = tid >> 4, sc = (tid & 15) * 8, vst0 = v_st(sr, sc), vst1 = v_st(32 + sr, sc);
  const int vb0 = (int)(uintptr_t)V_lds + v_rd_base(lane);
  struct { bf16x8 vs0, vs1, ks0, ks1; } sr_[2];
#define SLOAD(i, k0) do { sr_[i].vs0 = *(const bf16x8*)(&Vh[(long)((k0) + sr) * LDK + sc]); sr_[i].vs1 = *(const bf16x8*)(&Vh[(long)((k0) + 32 + sr) * LDK + sc]); \
    sr_[i].ks0 = *(const bf16x8*)(&Kh[(long)((k0) + sr) * LDK + sc]); sr_[i].ks1 = *(const bf16x8*)(&Kh[(long)((k0) + 32 + sr) * LDK + sc]); } while (0)
#define SWRITE(b, i) do { *(bf16x8*)((char*)V_lds + (b) * SHM_V + vst0) = sr_[i].vs0;          \
    *(bf16x8*)((char*)V_lds + (b) * SHM_V + vst1) = sr_[i].vs1; int kc = sc * 2;               \
    *(bf16x8*)((char*)K_lds + (b) * SHM_K + KSWZ(sr, kc)) = sr_[i].ks0;                       \
    *(bf16x8*)((char*)K_lds + (b) * SHM_K + KSWZ(32 + sr, kc)) = sr_[i].ks1; } while (0)
#define SWAIT() asm volatile("s_waitcnt vmcnt(4)" ::: "memory")
#define RESC(a) do { if (__any((a) < 1.f)) { if (hi == 0) al_l[r32] = (a); asm volatile("s_waitcnt lgkmcnt(0)" ::: "memory"); \
    for (int d = 0; d < 4; ++d) for (int r = 0; r < 16; ++r) o[d][r] *= al_l[crow(r, hi)]; } } while (0)
  f32x16 pA0, pA1, pB0, pB1; float mnA, mnB, alA, alB; bf16x8 pa0, pa1, pa2, pa3; const int NT = seq / KVBLK;
  constexpr int SE = 0, SO = 1;
  SLOAD(SE, 0); asm volatile("s_waitcnt vmcnt(0)" ::: "memory"); SWRITE(0, SE); __syncthreads();
  qkt(pA0, pA1, K_lds, qr, r32, hi, 0.f); partialSM(pA0, pA1, m_reg, mnA, alA);
  SLOAD(SO, KVBLK); if (2 < NT) SLOAD(SE, 2 * KVBLK);
  SWAIT(); SWRITE(1, SO); __syncthreads();
  for (int j = 1; j + 1 < NT; j += 2) {
    SBAR(); qkt(pB0, pB1, (bf16_t*)((char*)K_lds + SHM_K), qr, r32, hi, -m_reg);
    finishSM(pA0, pA1, alA, l_reg, pa0, pa1, pa2, pa3); SBAR();
    SLOAD(SO, (j + 2) * KVBLK); SBAR();
    pv_sm(o, vb0, pa0, pa1, pa2, pa3, pB0, pB1, m_reg, mnB, alB);
    __syncthreads(); SWAIT(); SWRITE(0, SE);
    RESC(alB); __syncthreads();
    SBAR(); qkt(pA0, pA1, K_lds, qr, r32, hi, -m_reg);
    finishSM(pB0, pB1, alB, l_reg, pa0, pa1, pa2, pa3); SBAR();
    if (j + 3 < NT) SLOAD(SE, (j + 3) * KVBLK); SBAR();
    pv_sm(o, vb0 + (int)SHM_V, pa0, pa1, pa2, pa3, pA0, pA1, m_reg, mnA, alA);
    __syncthreads(); SWAIT(); SWRITE(1, SO);
    RESC(alA); __syncthreads();
  }
  SBAR(); qkt(pB0, pB1, (bf16_t*)((char*)K_lds + SHM_K), qr, r32, hi, -m_reg);
  finishSM(pA0, pA1, alA, l_reg, pa0, pa1, pa2, pa3); SBAR();
  pv_sm(o, vb0, pa0, pa1, pa2, pa3, pB0, pB1, m_reg, mnB, alB);
  __syncthreads(); RESC(alB);
  finishSM(pB0, pB1, alB, l_reg, pa0, pa1, pa2, pa3); SBAR();
  pv_d0(o, vb0 + (int)SHM_V, pa0, pa1, pa2, pa3);
  if (hi == 0) li_l[r32] = l_reg; asm volatile("s_waitcnt lgkmcnt(0)" ::: "memory");
  float rli[16];
#pragma unroll
  for (int r = 0; r < 16; ++r) rli[r] = __builtin_amdgcn_rcpf(li_l[crow(r, hi)]);
  __syncthreads();
  int tz = threadIdx.x; asm volatile("" : "+v"(tz));
  const int lane_e = tz & 63, wid_e = tz >> 6, r32e = lane_e & 31, hie = lane_e >> 5;
  bf16_t* Ow = Ob + (long)(wid_e * QBLK) * LDO;
  char* ost = lds + wid_e * 8704;
#pragma unroll
  for (int r = 0; r < 16; ++r) { int orow = crow(r, hie);
#pragma unroll
    for (int d0 = 0; d0 < 4; ++d0) *(bf16_t*)(ost + orow * 272 + (d0 * 32 + r32e) * 2) = (bf16_t)(cvt_pk_bf16(o[d0][r] * rli[r], 0.f) & 0xffffu); }
  asm volatile("s_waitcnt lgkmcnt(0)" ::: "memory");
#pragma unroll
  for (int i = 0; i < 8; ++i) { const int row = i * 4 + (lane_e >> 4), ch = lane_e & 15;
    const u32x4 v = *(const u32x4*)(ost + row * 272 + ch * 16); *(u32x4*)(Ow + (long)row * LDO + ch * 8) = v; }
  __syncthreads();
#undef SLOAD
#undef SWRITE
#undef SWAIT
#undef RESC
}
}

__device__ __forceinline__ void gmlp_item(const Ctx& F, const Args& A, int item) {
    const int g = item & 7, nq = (item >> 3) & 3, b = item >> 5;
    const int c0 = g * 128;
    LAS unsigned char* T = F.lds;
    const bf16_t* VG = (const bf16_t*)(F.ws + WS_VG); const bf16_t* U = (const bf16_t*)(F.ws + WS_U); bf16_t* GM = (bf16_t*)(F.ws + WS_GM);
    const int wr = F.wave >> 2, wc = F.wave & 3, fr = F.lane & 15, fq = F.lane >> 4;
    const int q = F.tid >> 2, seg = F.tid & 3;
    u32x4 raw[4], rawn[4]; f32x4 lw[8]; bf16x8 af[4][4]; u32x2 uu[4][2], uun[4][2]; float bsv[4];
#define GM_LOAD(RAW, UU, row0_) do { const bf16_t* src_ = VG + (size_t)((row0_) + q) * GMW + c0 + seg * 32; \
        _Pragma("unroll") for (int i = 0; i < 4; ++i) RAW[i] = __builtin_nontemporal_load((const u32x4*)(src_ + i * 8)); \
        _Pragma("unroll") for (int m = 0; m < 4; ++m) { const int p_ = wr * 64 + m * 16 + fr; \
            _Pragma("unroll") for (int nn = 0; nn < 2; ++nn) UU[m][nn] = __builtin_nontemporal_load((const u32x2*)(U + (size_t)((row0_) + p_) * GMW + c0 + wc * 32 + nn * 16 + 4 * fq)); } } while (0)
    const int rowb = b * SEQ + nq * 512;
    GM_LOAD(raw, uu, rowb);
    { const float* lnw = A.in[I_GMLN] + c0 + seg * 32;
#pragma unroll
      for (int i = 0; i < 8; ++i) lw[i] = *(const f32x4*)(lnw + i * 4); }
    const bf16_t* WsB = (const bf16_t*)(F.ws + WS_WSB) + (size_t)g * 128 * 128;
#pragma unroll
    for (int kk = 0; kk < 4; ++kk)
#pragma unroll
        for (int m = 0; m < 4; ++m) af[kk][m] = *(const bf16x8*)(WsB + (size_t)(wr * 64 + m * 16 + fr) * 128 + kk * 32 + fq * 8);
#pragma unroll
    for (int m = 0; m < 4; ++m) bsv[m] = A.in[I_BS][g * 128 + wr * 64 + m * 16 + fr];
#pragma unroll 1
    for (int ch = 0; ch < 4; ++ch) { const int row0 = rowb + ch * 128;
        { float v[32];
#pragma unroll
          for (int i = 0; i < 4; ++i) { v[i * 8 + 0] = bf_lo(raw[i].x); v[i * 8 + 1] = bf_hi(raw[i].x); v[i * 8 + 2] = bf_lo(raw[i].y); v[i * 8 + 3] = bf_hi(raw[i].y); v[i * 8 + 4] = bf_lo(raw[i].z); v[i * 8 + 5] = bf_hi(raw[i].z); v[i * 8 + 6] = bf_lo(raw[i].w); v[i * 8 + 7] = bf_hi(raw[i].w); }
          if (ch < 3) {
              const bf16_t* src_ = VG + (size_t)(row0 + 128 + q) * GMW + c0 + seg * 32;
#pragma unroll
              for (int i = 0; i < 4; ++i) rawn[i] = __builtin_nontemporal_load((const u32x4*)(src_ + i * 8)); }
          float s = 0.f;
#pragma unroll
          for (int i = 0; i < 32; ++i) s += v[i];
          s += dppf<0xB1>(s); s += dppf<0x4E>(s);
          const float mean = s * (1.0f / 128.0f); float s2 = 0.f;
#pragma unroll
          for (int i = 0; i < 32; ++i) { v[i] -= mean; s2 += v[i] * v[i]; }
          s2 += dppf<0xB1>(s2); s2 += dppf<0x4E>(s2);
          const float rstd = 1.0f / sqrtf(s2 * (1.0f / 128.0f) + EPS);
#pragma unroll
          for (int i = 0; i < 32; ++i) { const float y = v[i] * rstd * lw[i >> 2][i & 3]; *(LAS bf16_t*)(T + (seg * 32 + i) * 272 + q * 2) = (bf16_t)(cvt_pk_bf16(y, 0.f) & 0xffffu); } }
        __syncthreads();
        f32x4 acc[4][2];
#pragma unroll
        for (int m = 0; m < 4; ++m) { acc[m][0] = (f32x4){0.f, 0.f, 0.f, 0.f}; acc[m][1] = (f32x4){0.f, 0.f, 0.f, 0.f}; }
#pragma unroll
        for (int kk = 0; kk < 4; ++kk) {
            bf16x8 bfr[2];
#pragma unroll
            for (int nn = 0; nn < 2; ++nn) bfr[nn] = *(const LAS bf16x8*)(T + (wc * 32 + nn * 16 + fr) * 272 + (kk * 32 + fq * 8) * 2);
#pragma unroll
            for (int m = 0; m < 4; ++m)
#pragma unroll
                for (int nn = 0; nn < 2; ++nn) acc[m][nn] = __builtin_amdgcn_mfma_f32_16x16x32_bf16(bfr[nn], af[kk][m], acc[m][nn], 0, 0, 0);
        }
#pragma unroll
        for (int m = 0; m < 4; ++m) { const int p = wr * 64 + m * 16 + fr;
#pragma unroll
            for (int nn = 0; nn < 2; ++nn) { const int c = c0 + wc * 32 + nn * 16 + 4 * fq; const size_t off = (size_t)(row0 + p) * GMW + c;
                const f32x4 sv = acc[m][nn] + bsv[m];
                *(u32x2*)(GM + off) = (u32x2){cvt_pk_bf16(bf_lo(uu[m][nn].x) * sv[0], bf_hi(uu[m][nn].x) * sv[1]), cvt_pk_bf16(bf_lo(uu[m][nn].y) * sv[2], bf_hi(uu[m][nn].y) * sv[3])};
                if (ch < 3) uu[m][nn] = __builtin_nontemporal_load((const u32x2*)(U + (size_t)(row0 + 128 + p) * GMW + c)); } }
#pragma unroll
        for (int i = 0; i < 4; ++i) raw[i] = rawn[i];
        __syncthreads();
    }
#undef GM_LOAD
}

__device__ __forceinline__ void p4_attention(const Ctx& F, const Args& A, char* lds_generic, int rep) {
    unsigned* const cb = F.ctl; (void)rep;
    modf_finalize(F, A);
    if (((F.bx >> 3) & 7) < NCONV8) { convert_strips<1>(F, A, cb + CW_STRIP2); convert_strips<2>(F, A, cb + CW_WORK2); __syncthreads(); }
    const bf16_t* Q = (const bf16_t*)(F.ws + WS_Q); const bf16_t* KN = (const bf16_t*)(F.ws + WS_KN); const bf16_t* V = (const bf16_t*)(F.ws + WS_V); bf16_t* O = (bf16_t*)(F.ws + WS_ATT);
    const int xl = F.bx & 7;
    for (;;) {
        LAS unsigned* bw = (LAS unsigned*)(F.lds + LDS_MISC);
        if (F.tid == 0) bw[0] = __hip_atomic_fetch_add(cb + CW_QA + 64 * xl, 1u, RLX_AGENT);
        __syncthreads();
        const int id = (int)bw[0];
        __syncthreads();
        if (id >= 64) break;
        const int grp = xl + 8 * (id >> 5), w = id & 31, b = grp >> 1, kvh = grp & 1, h = kvh * 4 + (w >> 3), qb = w & 7;
        const size_t qoff = ((size_t)(b * SEQ + qb * 256)) * QW + h * HD, koff = (size_t)b * LK * KVW + kvh * HD;
        att::attn_dense_body(Q + qoff, KN + koff, V + koff, O + qoff, LK, lds_generic);
    }
    for (;;) {
        LAS unsigned* bw = (LAS unsigned*)(F.lds + LDS_MISC);
        if (F.tid == 0) bw[0] = __hip_atomic_fetch_add(cb + CW_QB + 64 * xl, 1u, RLX_AGENT);
        __syncthreads();
        const int id = (int)bw[0];
        __syncthreads();
        if (id >= 32) break;
        gmlp_item(F, A, xl * 32 + id);
    }
}

__device__ __forceinline__ void row_max_exchange(LAS unsigned char* lds, unsigned long long* X  , unsigned* tmo, int pn, int ew, int tid, float* scale_out  ) {
    LAS float* M = (LAS float*)(lds + XCH_M); LAS float* R = (LAS float*)(lds + XCH_R);
    asm volatile("s_waitcnt lgkmcnt(0)" ::: "memory"); __builtin_amdgcn_s_barrier(); asm volatile("" ::: "memory");
    if (ew < 4) { const f32x4 m4 = *(const LAS f32x4*)(M + tid * 4); const float v = fmaxf(fmaxf(m4.x, m4.y), fmaxf(m4.z, m4.w));
        __hip_atomic_store(X + pn * 256 + tid, (1ull << 32) | (unsigned long long)__float_as_uint(v), RLX_AGENT);
        float r = 1e-20f; unsigned sp = 0;
        for (;;) { bool ok = true; r = 1e-20f;
#pragma unroll
            for (int q = 0; q < 8; ++q) { const unsigned long long g = __hip_atomic_load(X + q * 256 + tid, RLX_AGENT); ok &= (unsigned)(g >> 32) == 1u; r = fmaxf(r, __uint_as_float((unsigned)g)); }
            if (__all(ok)) break;
            __builtin_amdgcn_s_sleep(1);
            if (++sp > (1u << 20)) { if ((tid & 63) == 0) __hip_atomic_store(tmo, 0xE8u, RLX_AGENT); break; } }
        R[tid] = r; if (scale_out) scale_out[tid] = r * (1.0f / 127.0f); }
    asm volatile("s_waitcnt lgkmcnt(0)" ::: "memory"); __builtin_amdgcn_s_barrier(); asm volatile("" ::: "memory");
}

__device__ __forceinline__ void p5_quant_rows(const Ctx& F) {
    const int rl = F.tid >> 4, seg = F.tid & 15;
    for (int rb = F.bx; rb < NTOK / 64; rb += F.G) {
    u32x4 v[4][8];
#pragma unroll
    for (int sh = 0; sh < 4; ++sh) { const int row = rb * 64 + (sh & 1) * 32 + rl; const bf16_t* src = (const bf16_t*)(F.ws + ((sh >> 1) ? WS_GM : WS_ATT)) + (size_t)row * 1024 + seg * 8;
#pragma unroll
        for (int j = 0; j < 8; ++j) v[sh][j] = __builtin_nontemporal_load((const u32x4*)(src + j * 128)); }
#pragma unroll
    for (int sh = 0; sh < 4; ++sh) { const int row = rb * 64 + (sh & 1) * 32 + rl; float mx = 0.f;
#pragma unroll
        for (int j = 0; j < 8; ++j)
#pragma unroll
            for (int e = 0; e < 4; ++e) mx = fmaxf(mx, fmaxf(fabsf(bf_lo(v[sh][j][e])), fabsf(bf_hi(v[sh][j][e]))));
        mx = fmaxf(mx, dppf<0xB1>(mx)); mx = fmaxf(mx, dppf<0x4E>(mx)); mx = fmaxf(mx, dppf<0x124>(mx)); mx = fmaxf(mx, dppf<0x128>(mx));
        mx = fmaxf(mx, 1e-20f); const float inv = 127.0f / mx;
        if (seg == 0) ((float*)(F.ws + ((sh >> 1) ? WS_SAGM : WS_SAATT)))[row] = mx * (1.0f / 127.0f);
        signed char* dst = (signed char*)(F.ws + ((sh >> 1) ? WS_GM8 : WS_ATT8)) + (size_t)row * 1024 + seg * 8;
#pragma unroll
        for (int j = 0; j < 8; ++j) { const u32x4 w = v[sh][j];
            *(u32x2*)(dst + j * 128) = (u32x2){q8x4m((f32x4){bf_lo(w.x), bf_hi(w.x), bf_lo(w.y), bf_hi(w.y)}, inv), q8x4m((f32x4){bf_lo(w.z), bf_hi(w.z), bf_lo(w.w), bf_hi(w.w)}, inv)}; } }
    }
}
struct SchedF1 {
    unsigned char* ws; int G, c;
    __device__ __forceinline__ bool next(int i, pg8::Unit& u) const {
        const int ir = i >> 1, pass = i & 1; if (ir * G + c >= 512) return false;
        const int w = (c >> 3) + (G >> 3) * ir, pm = 8 * (c & 7) + (w >> 3), pn = w & 7;
        u.pm = pm; u.pn = pn; u.e = pass; u.slot = 0;
        u.a = (const char*)(ws + (pass ? WS_GM8 : WS_ATT8)) + (size_t)pm * (256 * 1024); u.b = (const char*)(ws + (pass ? WS_WBG : WS_WBA)) + (size_t)pn * (256 * 1024); return true;
    }
};
struct EpiF1 {
    static constexpr bool PERM = true, PRE = false;
    unsigned char* ws; unsigned* ctl;
    __device__ __forceinline__ void operator()(const i32x4 (&acc)[2][2][4][2], const pg8::Unit& u, int wr, int wc, int fr, int fq, LAS unsigned char* lds) const {
        const unsigned char* gate = (const unsigned char*)(ws + (u.e ? WS_GG : WS_GA)); bf16_t* mg = (bf16_t*)(ws + WS_MG);
        const size_t off0 = (size_t)(u.pm * 256 + wr * 64 + fr) * DM + u.pn * 256 + wc * 32 + 8 * fq;
        const float* sap = (const float*)(ws + (u.e ? WS_SAGM : WS_SAATT)) + u.pm * 256 + wr * 64 + fr;
        const float* sbp = (const float*)(ws + (u.e ? WS_SBBG : WS_SBBA)) + u.pn * 256 + wc * 32 + 8 * fq;
        if (!u.e) {
            f32x4 sb[2][2];
#pragma unroll
            for (int bj = 0; bj < 2; ++bj) { sb[bj][0] = *(const f32x4*)(sbp + bj * 128); sb[bj][1] = *(const f32x4*)(sbp + bj * 128 + 4); }
            u32x2 gt[2][4][2]; float sa[2][4];
#pragma unroll
            for (int ai = 0; ai < 2; ++ai)
#pragma unroll
                for (int m = 0; m < 4; ++m) { sa[ai][m] = sap[ai * 128 + m * 16];
#pragma unroll
                    for (int bj = 0; bj < 2; ++bj) gt[ai][m][bj] = __builtin_nontemporal_load((const u32x2*)(gate + off0 + (size_t)(ai * 128 + m * 16) * DM + bj * 128)); }
#pragma unroll
            for (int ai = 0; ai < 2; ++ai) {
#pragma unroll
                for (int m = 0; m < 4; ++m) { const float sk = sa[ai][m] * (1.0f / 255.0f);
#pragma unroll
                    for (int bj = 0; bj < 2; ++bj) { const size_t off = off0 + (size_t)(ai * 128 + m * 16) * DM + bj * 128;
                        const u32x2 g = gt[ai][m][bj]; f32x4 v0, v1;
#pragma unroll
                        for (int j = 0; j < 4; ++j) { v0[j] = (float)acc[ai][bj][m][0][j] * sk * sb[bj][0][j]; v1[j] = (float)acc[ai][bj][m][1][j] * sk * sb[bj][1][j]; }
                        *(u32x4*)(mg + off) = (u32x4){cvt_pk_bf16((float)(g.x & 0xffu) * v0[0], (float)((g.x >> 8) & 0xffu) * v0[1]), cvt_pk_bf16((float)((g.x >> 16) & 0xffu) * v0[2], (float)(g.x >> 24) * v0[3]),
                                                        cvt_pk_bf16((float)(g.y & 0xffu) * v1[0], (float)((g.y >> 8) & 0xffu) * v1[1]), cvt_pk_bf16((float)((g.y >> 16) & 0xffu) * v1[2], (float)(g.y >> 24) * v1[3])}; } } }
            return; }
        LAS float* M = (LAS float*)(lds + XCH_M); const LAS float* R = (const LAS float*)(lds + XCH_R);
        unsigned mvp[2][4][2][4];
        LAS float* sbl = (LAS float*)(lds + LDS_TAB);
        { int tz = threadIdx.x; asm volatile("" : "+v"(tz)); if (tz < 64) *(LAS f32x4*)(sbl + tz * 4) = *(const f32x4*)((const float*)(ws + WS_SBBG) + u.pn * 256 + tz * 4); }
        asm volatile("s_waitcnt lgkmcnt(0)" ::: "memory"); __builtin_amdgcn_s_barrier(); asm volatile("" ::: "memory");
        const LAS float* sbq = sbl + wc * 32 + 8 * fq;
        u32x2 gt[3][2]; u32x4 pr[3][2]; float sa[3];
#define F1B_LOAD(g_, buf_) do { const int rg_ = ((g_) >> 2) * 128 + ((g_) & 3) * 16; sa[buf_] = sap[rg_]; \
            _Pragma("unroll") for (int bj = 0; bj < 2; ++bj) { const size_t off_ = off0 + (size_t)rg_ * DM + bj * 128; gt[buf_][bj] = __builtin_nontemporal_load((const u32x2*)(gate + off_)); pr[buf_][bj] = __builtin_nontemporal_load((const u32x4*)(mg + off_)); } } while (0)
        F1B_LOAD(0, 0); F1B_LOAD(1, 1);
#pragma unroll
        for (int g8 = 0; g8 < 8; ++g8) { const int ai = g8 >> 2, m = g8 & 3, cb = g8 % 3;
            if (g8 + 2 < 8) { if ((g8 + 2) % 3 == 0) F1B_LOAD(g8 + 2, 0); else if ((g8 + 2) % 3 == 1) F1B_LOAD(g8 + 2, 1); else F1B_LOAD(g8 + 2, 2); }
            __builtin_amdgcn_sched_barrier(0);
            { float mx = 0.f; const float k = sa[cb] * (1.0f / 255.0f);
#pragma unroll
                for (int bj = 0; bj < 2; ++bj) { const u32x2 g = gt[cb][bj]; const u32x4 p = pr[cb][bj]; const i32x4 a0 = acc[ai][bj][m][0], a1 = acc[ai][bj][m][1]; const f32x4 s0 = *(const LAS f32x4*)(sbq + bj * 128) * k, s1 = *(const LAS f32x4*)(sbq + bj * 128 + 4) * k;
                    float r[8];
                    r[0] = fmaf((float)a0[0], (float)(g.x & 0xffu) * s0[0], bf_lo(p.x)); r[1] = fmaf((float)a0[1], (float)((g.x >> 8) & 0xffu) * s0[1], bf_hi(p.x)); r[2] = fmaf((float)a0[2], (float)((g.x >> 16) & 0xffu) * s0[2], bf_lo(p.y)); r[3] = fmaf((float)a0[3], (float)(g.x >> 24) * s0[3], bf_hi(p.y));
                    r[4] = fmaf((float)a1[0], (float)(g.y & 0xffu) * s1[0], bf_lo(p.z)); r[5] = fmaf((float)a1[1], (float)((g.y >> 8) & 0xffu) * s1[1], bf_hi(p.z)); r[6] = fmaf((float)a1[2], (float)((g.y >> 16) & 0xffu) * s1[2], bf_lo(p.w)); r[7] = fmaf((float)a1[3], (float)(g.y >> 24) * s1[3], bf_hi(p.w));
#pragma unroll
                    for (int q = 0; q < 8; ++q) mx = fmaxf(mx, fabsf(r[q]));
#pragma unroll
                    for (int q = 0; q < 4; ++q) mvp[ai][m][bj][q] = cvt_pk_bf16(r[2 * q], r[2 * q + 1]); }
                mx = pmax32(pmax16(mx));
                if (fq == 0) M[(ai * 128 + wr * 64 + m * 16 + fr) * 4 + wc] = mx; }
            asm volatile("" ::: "memory"); __builtin_amdgcn_sched_barrier(0); }
#undef F1B_LOAD
        const int ew = __builtin_amdgcn_readfirstlane(wr * 4 + wc), tid = ew * 64 + fq * 16 + fr;
        row_max_exchange(lds, (unsigned long long*)(ws + WS_XCH2) + (size_t)u.pm * 8 * 256, ctl + CW_TMO, u.pn, ew, tid, u.pn == 0 ? (float*)(ws + WS_SAMG) + u.pm * 256 : nullptr);
        signed char* mg8 = (signed char*)(ws + WS_MG8);
        int tz2 = tid; asm volatile("" : "+v"(tz2));
        const int fr2 = tz2 & 15, fq2 = (tz2 >> 4) & 3, wr2 = tz2 >> 8, wc2 = (tz2 >> 6) & 3;
        const size_t off0b = (size_t)(u.pm * 256 + wr2 * 64 + fr2) * DM + u.pn * 256 + wc2 * 32 + 8 * fq2;
#pragma unroll
        for (int ai = 0; ai < 2; ++ai)
#pragma unroll
            for (int m = 0; m < 4; ++m) { const float inv = 127.0f / R[ai * 128 + wr2 * 64 + m * 16 + fr2];
#pragma unroll
                for (int bj = 0; bj < 2; ++bj) { const unsigned* r = mvp[ai][m][bj];
                    *(u32x2*)(mg8 + off0b + (size_t)(ai * 128 + m * 16) * DM + bj * 128) = (u32x2){q8x4m((f32x4){bf_lo(r[0]), bf_hi(r[0]), bf_lo(r[1]), bf_hi(r[1])}, inv), q8x4m((f32x4){bf_lo(r[2]), bf_hi(r[2]), bf_lo(r[3]), bf_hi(r[3])}, inv)}; } }
    }
};

struct SchedF2 {
    unsigned char* ws; int G, c;
    __device__ __forceinline__ bool next(int i, pg8::Unit& u) const {
        const int L = i * G + c; if (L >= 512) return false;
        int pm, pn; pg8::static_map(L, 64, 8, pm, pn);
        u.pm = pm; u.pn = pn; u.e = 0; u.slot = 0;
        u.a = (const char*)(ws + WS_MG8) + (size_t)pm * (256 * 2048); u.b = (const char*)(ws + WS_WO) + (size_t)pn * (256 * 2048); return true;
    }
};
struct EpiF2 {
    static constexpr bool PERM = true, PRE = true;
    unsigned char* ws;
    __device__ __forceinline__ void pre_addr(const pg8::Unit& u, int t, const float*& pa, const float*& pb) const { pa = (const float*)(ws + WS_SAMG) + u.pm * 256 + t; pb = (const float*)(ws + WS_SBWO) + u.pn * 256 + t; }
    __device__ __forceinline__ void operator()(const i32x4 (&acc)[2][2][4][2], const pg8::Unit& u, int wr, int wc, int fr, int fq, LAS unsigned char* lds) const {
        bf16_t* mix = (bf16_t*)(ws + WS_MIX); const LAS float* sap = (const LAS float*)(lds + PRE_OFF);
        const LAS float* sbp = (const LAS float*)(lds + PRE_OFF) + 256 + wc * 32 + 8 * fq;
        f32x4 sb[2][2];
#pragma unroll
        for (int bj = 0; bj < 2; ++bj) { sb[bj][0] = *(const LAS f32x4*)(sbp + bj * 128); sb[bj][1] = *(const LAS f32x4*)(sbp + bj * 128 + 4); }
        float sa8[2][4];
#pragma unroll
        for (int ai = 0; ai < 2; ++ai)
#pragma unroll
            for (int m = 0; m < 4; ++m) sa8[ai][m] = sap[ai * 128 + wr * 64 + m * 16 + fr];
#pragma unroll
        for (int ai = 0; ai < 2; ++ai)
#pragma unroll
            for (int m = 0; m < 4; ++m) { const int row = u.pm * 256 + ai * 128 + wr * 64 + m * 16 + fr; const float sa = sa8[ai][m];
#pragma unroll
                for (int bj = 0; bj < 2; ++bj) { f32x4 v0, v1;
#pragma unroll
                    for (int j = 0; j < 4; ++j) { v0[j] = (float)acc[ai][bj][m][0][j] * sa * sb[bj][0][j]; v1[j] = (float)acc[ai][bj][m][1][j] * sa * sb[bj][1][j]; }
                    *(u32x4*)(mix + (size_t)row * DM + u.pn * 256 + bj * 128 + wc * 32 + 8 * fq) = (u32x4){cvt_pk_bf16(v0[0], v0[1]), cvt_pk_bf16(v0[2], v0[3]), cvt_pk_bf16(v1[0], v1[1]), cvt_pk_bf16(v1[2], v1[3])}; } }
    }
};

constexpr int P7_RS = 4160;
constexpr int P7_LO = 16 * P7_RS;
__device__ __forceinline__ void p7_router(const Ctx& F, const Args& A, bool dummy) {
    const float* x = A.in[I_X]; const bf16_t* mix = (const bf16_t*)(F.ws + WS_MIX); bf16_t* x1b = (bf16_t*)(F.ws + WS_X1); signed char* H2 = (signed char*)(F.ws + WS_H2);
    const int fr = F.lane & 15, fq = F.lane >> 4;
    f32x4 xr[2][8]; u32x2 mr[2][8];
#define P7_LOAD1(tile_, rr) do { const size_t ro_ = (size_t)((tile_) * 16 + 2 * F.wave + (rr)) * DM + F.lane * 4; \
        _Pragma("unroll") for (int j = 0; j < 8; ++j) { xr[rr][j] = __builtin_nontemporal_load((const f32x4*)(x + ro_ + 256 * j)); mr[rr][j] = __builtin_nontemporal_load((const u32x2*)(mix + ro_ + 256 * j)); } } while (0)
#define P7_LOAD(tile_) do { P7_LOAD1(tile_, 0); P7_LOAD1(tile_, 1); } while (0)
    LAS float* modl = (LAS float*)(F.lds + 133120);
    LAS float* rb = (LAS float*)(F.lds + 157696);
    if (F.tid < 32) rb[F.tid] = A.in[I_BRE][F.tid]; else if (F.tid < 36) rb[F.tid] = A.in[I_BRG][F.tid - 32];
    const int TPW = (NTOK / 16 + F.G - 1) / F.G, tend = ((F.vcu + 1) * TPW < NTOK / 16) ? (F.vcu + 1) * TPW : NTOK / 16;
    int tile = F.vcu * TPW, curb = -1;
    if (tile < tend) P7_LOAD(tile);
    for (; tile < tend; ++tile) {
        const int r0 = tile * 16, b = r0 >> 11;
        if (b != curb) { curb = b; __syncthreads();
            const f32x4* msrc = (const f32x4*)((const float*)(F.ws + WS_MODF) + (size_t)b * 4 * DM);
#pragma unroll
            for (int k = 0; k < 3; ++k) *(LAS f32x4*)(modl + (F.tid + 512 * k) * 4) = msrc[F.tid + 512 * k];
            __syncthreads(); }
        const LAS float* modf = modl;
#pragma unroll
        for (int rr = 0; rr < 2; ++rr) { const int rl = 2 * F.wave + rr; const size_t ro = (size_t)(r0 + rl) * DM + F.lane * 4;
            f32x4 z[8]; float s = 0.f;
#pragma unroll
            for (int j = 0; j < 8; ++j) { const f32x4 m = (f32x4){bf_lo(mr[rr][j].x), bf_hi(mr[rr][j].x), bf_lo(mr[rr][j].y), bf_hi(mr[rr][j].y)};
                s += (m.x * m.x + m.y * m.y) + (m.z * m.z + m.w * m.w); z[j] = m * *(const LAS f32x4*)(modf + F.lane * 4 + 256 * j); }
            s = wave_sum(s);
            const float rs_mix = 1.0f / sqrtf(s * (1.0f / DM) + EPS); float s1 = 0.f;
#pragma unroll
            for (int j = 0; j < 8; ++j) { z[j] = xr[rr][j] + z[j] * rs_mix; s1 += (z[j].x * z[j].x + z[j].y * z[j].y) + (z[j].z * z[j].z + z[j].w * z[j].w); __builtin_nontemporal_store((u32x2){cvt_pk_bf16(z[j].x, z[j].y), cvt_pk_bf16(z[j].z, z[j].w)}, (u32x2*)(x1b + ro + 256 * j)); }
            if (tile + 1 < tend) P7_LOAD1(tile + 1, rr);
            s1 = wave_sum(s1);
            const float rs_x1 = 1.0f / sqrtf(s1 * (1.0f / DM) + EPS);
            float mx = 0.f;
#pragma unroll
            for (int j = 0; j < 8; ++j) { const int col = F.lane * 4 + 256 * j;
                const f32x4 h = z[j] * rs_x1 * *(const LAS f32x4*)(modf + DM + col) + *(const LAS f32x4*)(modf + 2 * DM + col); z[j] = h;
                mx = fmaxf(fmaxf(mx, fmaxf(fabsf(h.x), fabsf(h.y))), fmaxf(fabsf(h.z), fabsf(h.w)));
                const u32x2 hi = (u32x2){cvt_pk_bf16(h.x, h.y), cvt_pk_bf16(h.z, h.w)};
                const u32x2 lo = (u32x2){cvt_pk_bf16(h.x - bf_lo(hi.x), h.y - bf_hi(hi.x)), cvt_pk_bf16(h.z - bf_lo(hi.y), h.w - bf_hi(hi.y))};
                *(LAS u32x2*)(F.lds + rl * P7_RS + col * 2) = hi; *(LAS u32x2*)(F.lds + P7_LO + rl * P7_RS + col * 2) = lo; }
            mx = wave_max(mx);
            mx = fmaxf(mx, 1e-20f); const float inv = 127.0f / mx;
            if (F.lane == 0) ((float*)(F.ws + WS_SAH))[r0 + rl] = mx * (1.0f / 127.0f);
#pragma unroll
            for (int j = 0; j < 8; ++j) *(unsigned*)(H2 + ro + 256 * j) = q8x4m(z[j], inv); }
        __syncthreads();
        f32x4 lacc[3] = {(f32x4){0.f, 0.f, 0.f, 0.f}, (f32x4){0.f, 0.f, 0.f, 0.f}, (f32x4){0.f, 0.f, 0.f, 0.f}};
        const u32x4* wrf = (const u32x4*)(F.ws + WS_WRF) + F.lane;
#pragma unroll 2
        for (int q = 0; q < 8; ++q) { const int ks = F.wave * 8 + q;
            const bf16x8 ahi = *(const LAS bf16x8*)(F.lds + fr * P7_RS + (ks * 32 + fq * 8) * 2), alo = *(const LAS bf16x8*)(F.lds + P7_LO + fr * P7_RS + (ks * 32 + fq * 8) * 2);
#pragma unroll
            for (int nt3 = 0; nt3 < 3; ++nt3) { const u32x4 wh = wrf[(size_t)((ks * 3 + nt3) * 2 + 0) * 64], wl = wrf[(size_t)((ks * 3 + nt3) * 2 + 1) * 64];
                const bf16x8 bh = *reinterpret_cast<const bf16x8*>(&wh), bl = *reinterpret_cast<const bf16x8*>(&wl);
                lacc[nt3] = __builtin_amdgcn_mfma_f32_16x16x32_bf16(ahi, bh, lacc[nt3], 0, 0, 0);
                lacc[nt3] = __builtin_amdgcn_mfma_f32_16x16x32_bf16(alo, bh, lacc[nt3], 0, 0, 0);
                lacc[nt3] = __builtin_amdgcn_mfma_f32_16x16x32_bf16(ahi, bl, lacc[nt3], 0, 0, 0); } }
        __syncthreads();
        LAS float* lg = (LAS float*)(F.lds + F.wave * 4096);
#pragma unroll
        for (int nt3 = 0; nt3 < 3; ++nt3)
#pragma unroll
            for (int r = 0; r < 4; ++r) lg[((F.lane >> 4) * 4 + r) * 49 + nt3 * 16 + (F.lane & 15)] = lacc[nt3][r];
        __syncthreads();
        if (F.tid < 16) {
            const LAS float* L = (const LAS float*)F.lds + F.tid * 49; const int trow = r0 + F.tid;
            float gl[4]; float gm = -3.0e38f; int gi = 0;
#pragma unroll
            for (int i = 0; i < 4; ++i) { float v = rb[32 + i];
#pragma unroll
                for (int w = 0; w < 8; ++w) v += L[w * 1024 + 32 + i];
                gl[i] = v; if (v > gm) { gm = v; gi = i; } }
            float gz = 0.f;
#pragma unroll
            for (int i = 0; i < 4; ++i) gz += fexp2((gl[i] - gm) * 1.4426950408889634f);
            const float p_top = 1.0f / gz;
            float m0 = -3.0e38f, m1 = -3.0e38f; int i0 = 0, i1 = 0;
#pragma unroll
            for (int i = 0; i < 8; ++i) { float v = rb[gi * 8 + i];
#pragma unroll
                for (int w = 0; w < 8; ++w) v += L[w * 1024 + gi * 8 + i];
                if (v > m0) { m1 = m0; i1 = i0; m0 = v; i0 = i; } else if (v > m1) { m1 = v; i1 = i; } }
            const float r = fexp2((m1 - m0) * 1.4426950408889634f);
            const float w0 = p_top / (1.0f + r), w1 = p_top * r / (1.0f + r);
            const int e0 = gi * 8 + i0, e1 = gi * 8 + i1;
            unsigned* cntb = F.ctl + CW_CNT; (void)dummy;
            const unsigned sl0 = __hip_atomic_fetch_add(cntb + 64 * e0, 1u, RLX_AGENT);
            const unsigned sl1 = __hip_atomic_fetch_add(cntb + 64 * e1, 1u, RLX_AGENT);
            int* ltok = (int*)(F.ws + WS_LTOK); float* lw = (float*)(F.ws + WS_LW); int* ts = (int*)(F.ws + WS_TSLOT);
            ltok[e0 * CAP + sl0] = trow; lw[e0 * CAP + sl0] = w0; ltok[e1 * CAP + sl1] = trow; lw[e1 * CAP + sl1] = w1;
            ts[trow * 2] = e0 * CAP + (int)sl0; ts[trow * 2 + 1] = e1 * CAP + (int)sl1;
        }
        __syncthreads();
    }
#undef P7_LOAD
#undef P7_LOAD1
}

__device__ __forceinline__ int moe_tables(const Ctx& F, bool rows) {
    LAS int* cnt = (LAS int*)(F.lds + TAB_CNT); LAS int* tbase = (LAS int*)(F.lds + TAB_TBASE); LAS int* tilee = (LAS int*)(F.lds + TAB_TILEE);
    LAS int* ud = (LAS int*)(F.lds + TAB_UDESC);
    if (F.tid < 32) cnt[F.tid] = (int)__hip_atomic_load(F.ctl + CW_CNT + 64 * F.tid, RLX_AGENT);
    __syncthreads();
    if (F.tid == 0) { int s = 0; for (int e = 0; e < 32; ++e) { tbase[e] = s; s += (cnt[e] + 255) >> 8; } tbase[32] = s; }
    __syncthreads();
    const int T = tbase[32];
    if (F.tid < T && F.tid < 160) { int e = 0; for (int q = 1; q < 32; ++q) if (tbase[q] <= F.tid) e = q; tilee[F.tid] = e; }
    __syncthreads();
    int nu = (8 * T - F.vcu + F.G - 1) / F.G; nu = nu < 0 ? 0 : (nu > MAXU ? MAXU : nu);
    int tokv[MAXU]; float wv[MAXU]; int tv_[MAXU];
#pragma unroll
    for (int i = 0; i < MAXU; ++i) { tokv[i] = 0; wv[i] = 0.f; tv_[i] = 0;
        if (i < nu) { const int L = i * F.G + F.vcu; const int t = L >> 3, pn = L & 7, e = tilee[t], rowb = (t - tbase[e]) * 256; int nv = cnt[e] - rowb; nv = nv > 256 ? 256 : nv; tv_[i] = t;
            if (F.tid == 0) { ud[i * 4 + 0] = t; ud[i * 4 + 1] = pn; ud[i * 4 + 2] = e; ud[i * 4 + 3] = nv; }
            if (rows && F.tid < 256) { const int r = F.tid < nv ? F.tid : 0; tokv[i] = ((const int*)(F.ws + WS_LTOK))[(size_t)e * CAP + rowb + r]; wv[i] = F.tid < nv ? ((const float*)(F.ws + WS_LW))[(size_t)e * CAP + rowb + r] : 0.f; } } }
#pragma unroll
    for (int i = 0; i < MAXU; ++i) if (i < nu && F.tid < 256) {
        if (rows) { ((LAS unsigned*)(F.lds + TAB_ROWOFF))[i * 256 + F.tid] = (unsigned)tokv[i] * (unsigned)DM; ((LAS float*)(F.lds + TAB_W))[i * 256 + F.tid] = wv[i];
            wv[i] = ((const float*)(F.ws + WS_SAH))[tokv[i]]; }
        else wv[i] = ((const float*)(F.ws + WS_SAHID))[tv_[i] * 256 + F.tid]; }
#pragma unroll
    for (int i = 0; i < MAXU; ++i) if (i < nu && F.tid < 256) ((LAS float*)(F.lds + TAB_SA))[i * 256 + F.tid] = wv[i];
    __syncthreads();
    return nu;
}
struct SchedMoe {
    const LAS int* ud; int nu; const char* A; const char* B; size_t a_tile, b_exp, b_pn; bool gather;
    __device__ __forceinline__ bool next(int i, pg8::Unit& u) const {
        if (i >= nu) return false;
        const int t = __builtin_amdgcn_readfirstlane(ud[i * 4 + 0]), pn = __builtin_amdgcn_readfirstlane(ud[i * 4 + 1]), e = __builtin_amdgcn_readfirstlane(ud[i * 4 + 2]);
        u.pm = t; u.pn = pn; u.e = e; u.slot = i; u.a = gather ? A : A + (size_t)t * a_tile; u.b = B + (size_t)e * b_exp + (size_t)pn * b_pn; return true;
    }
};
struct EpiMoeUp {
    static constexpr bool PERM = true, PRE = false;
    unsigned char* ws; unsigned* ctl;
    __device__ __forceinline__ void operator()(const i32x4 (&acc)[2][2][4][2], const pg8::Unit& u, int wr, int wc, int fr, int fq, LAS unsigned char* lds) const {
        signed char* hid = (signed char*)(ws + WS_HID); const LAS float* wt = (const LAS float*)(lds + TAB_W) + u.slot * 256; const LAS float* st = (const LAS float*)(lds + TAB_SA) + u.slot * 256;
        const float* sbp = (const float*)(ws + WS_SBGU) + (size_t)u.e * 2048 + u.pn * 256 + wc * 32 + 8 * fq;
        LAS float* M = (LAS float*)(lds + XCH_M); LAS float* R = (LAS float*)(lds + XCH_R);
        f32x4 sb[2][2];
#pragma unroll
        for (int bj = 0; bj < 2; ++bj) { sb[bj][0] = *(const f32x4*)(sbp + bj * 128); sb[bj][1] = *(const f32x4*)(sbp + bj * 128 + 4); }
        float h[8][8];
#pragma unroll
        for (int ai = 0; ai < 2; ++ai)
#pragma unroll
            for (int m = 0; m < 4; ++m) { const int r = ai * 128 + wr * 64 + m * 16 + fr; const float w = wt[r], sa = st[r]; float mx = 0.f;
#pragma unroll
                for (int n = 0; n < 2; ++n)
#pragma unroll
                    for (int j = 0; j < 4; ++j) { const float v = siluf_((float)acc[ai][0][m][n][j] * sa * sb[0][n][j]) * ((float)acc[ai][1][m][n][j] * sa * sb[1][n][j]) * w; h[ai * 4 + m][n * 4 + j] = v; mx = fmaxf(mx, fabsf(v)); }
                mx = pmax32(pmax16(mx));
                if (fq == 0) M[r * 4 + wc] = mx; }
        const int ew = __builtin_amdgcn_readfirstlane(wr * 4 + wc), tid = ew * 64 + fq * 16 + fr;
        row_max_exchange(lds, (unsigned long long*)(ws + WS_XCH) + (size_t)u.pm * 8 * 256, ctl + CW_TMO, u.pn, ew, tid, u.pn == 0 ? (float*)(ws + WS_SAHID) + u.pm * 256 : nullptr);
#pragma unroll
        for (int ai = 0; ai < 2; ++ai)
#pragma unroll
            for (int m = 0; m < 4; ++m) { const int r = ai * 128 + wr * 64 + m * 16 + fr; const float inv = 127.0f / R[r]; const int q = ai * 4 + m;
                *(u32x2*)(hid + ((size_t)u.pm * 256 + r) * DEXP + u.pn * 128 + wc * 32 + 8 * fq) =
                    (u32x2){q8x4m((f32x4){h[q][0], h[q][1], h[q][2], h[q][3]}, inv), q8x4m((f32x4){h[q][4], h[q][5], h[q][6], h[q][7]}, inv)}; }
    }
};
struct EpiMoeDown {
    static constexpr bool PERM = true, PRE = false;
    unsigned char* ws;
    __device__ __forceinline__ void operator()(const i32x4 (&acc)[2][2][4][2], const pg8::Unit& u, int wr, int wc, int fr, int fq, LAS unsigned char* lds) const {
        unsigned char* y = (unsigned char*)(ws + WS_Y); const LAS float* st = (const LAS float*)(lds + TAB_SA) + u.slot * 256;
        const float* sbp = (const float*)(ws + WS_SBDN) + (size_t)u.e * 2048 + u.pn * 256 + wc * 32 + 8 * fq;
        f32x4 sb[2][2];
#pragma unroll
        for (int bj = 0; bj < 2; ++bj) { sb[bj][0] = *(const f32x4*)(sbp + bj * 128) * 32.0f; sb[bj][1] = *(const f32x4*)(sbp + bj * 128 + 4) * 32.0f; }
#pragma unroll
        for (int ai = 0; ai < 2; ++ai)
#pragma unroll
            for (int m = 0; m < 4; ++m) { const int r = ai * 128 + wr * 64 + m * 16 + fr; const float sa = st[r];
#pragma unroll
                for (int bj = 0; bj < 2; ++bj) { f32x4 v0, v1;
#pragma unroll
                    for (int j = 0; j < 4; ++j) { v0[j] = fminf(fmaxf((float)acc[ai][bj][m][0][j] * sa * sb[bj][0][j], -448.0f), 448.0f); v1[j] = fminf(fmaxf((float)acc[ai][bj][m][1][j] * sa * sb[bj][1][j], -448.0f), 448.0f); }
                    int p0 = 0, p1 = 0;
                    p0 = __builtin_amdgcn_cvt_pk_fp8_f32(v0[0], v0[1], p0, false); p0 = __builtin_amdgcn_cvt_pk_fp8_f32(v0[2], v0[3], p0, true);
                    p1 = __builtin_amdgcn_cvt_pk_fp8_f32(v1[0], v1[1], p1, false); p1 = __builtin_amdgcn_cvt_pk_fp8_f32(v1[2], v1[3], p1, true);
                    *(u32x2*)(y + ((size_t)u.pm * 256 + r) * DM + u.pn * 256 + bj * 128 + wc * 32 + 8 * fq) = (u32x2){(unsigned)p0, (unsigned)p1}; } }
    }
};

__device__ __forceinline__ void p10_final(const Ctx& F, const Args& A) {
    LAS int* cnt = (LAS int*)(F.lds + TAB_CNT); LAS int* tbase = (LAS int*)(F.lds + TAB_TBASE);
    if (F.tid < 32) cnt[F.tid] = (int)__hip_atomic_load(F.ctl + CW_CNT + 64 * F.tid, RLX_AGENT);
    __syncthreads();
    if (F.tid == 0) { int s = 0; for (int e = 0; e < 32; ++e) { tbase[e] = s; s += (cnt[e] + 255) >> 8; } tbase[32] = s; }
    __syncthreads();
    const int gw = F.vcu * NWAVES + F.wave, NGW = F.G * NWAVES;
    const unsigned char* Y = (const unsigned char*)(F.ws + WS_Y); const int* ts = (const int*)(F.ws + WS_TSLOT); float* out = A.out; const bf16_t* x1b = (const bf16_t*)(F.ws + WS_X1);
    int ya[8], yb[8], yan[8], ybn[8]; u32x2 xq[8], xqn[8]; f32x4 gq[8], gqn[8];
#define P10_DATA(row_, t0_, t1_, YA, YB, XQ, GQ) do { const size_t y0_ = (size_t)(tbase[(t0_) >> 14] * 256 + ((t0_) & (CAP - 1))), y1_ = (size_t)(tbase[(t1_) >> 14] * 256 + ((t1_) & (CAP - 1))); \
        const float* g2p_ = (const float*)(F.ws + WS_MODF) + (size_t)(((row_) >> 11) * 4 + 3) * DM; \
        _Pragma("unroll") for (int j = 0; j < 8; ++j) { const int col_ = F.lane * 4 + 256 * j; YA[j] = __builtin_nontemporal_load((const int*)(Y + y0_ * DM + col_)); YB[j] = __builtin_nontemporal_load((const int*)(Y + y1_ * DM + col_)); \
            XQ[j] = __builtin_nontemporal_load((const u32x2*)(x1b + (size_t)(row_) * DM + col_)); GQ[j] = *(const f32x4*)(g2p_ + col_); } } while (0)
    int row = gw; if (row >= NTOK) return;
    int c0 = ts[row * 2], c1 = ts[row * 2 + 1];
    int n0 = 0, n1 = 0; if (row + NGW < NTOK) { n0 = ts[(row + NGW) * 2]; n1 = ts[(row + NGW) * 2 + 1]; }
    P10_DATA(row, c0, c1, ya, yb, xq, gq);
    for (; row < NTOK; row += NGW) {
        int m0 = 0, m1 = 0; if (row + 2 * NGW < NTOK) { m0 = ts[(row + 2 * NGW) * 2]; m1 = ts[(row + 2 * NGW) * 2 + 1]; }
        if (row + NGW < NTOK) P10_DATA(row + NGW, n0, n1, yan, ybn, xqn, gqn);
        f32x4 v[8]; float sq = 0.f;
#pragma unroll
        for (int j = 0; j < 8; ++j) { const f32x2 a0 = __builtin_amdgcn_cvt_pk_f32_fp8(ya[j], false), a1 = __builtin_amdgcn_cvt_pk_f32_fp8(ya[j], true), b0 = __builtin_amdgcn_cvt_pk_f32_fp8(yb[j], false), b1 = __builtin_amdgcn_cvt_pk_f32_fp8(yb[j], true);
            v[j] = (f32x4){a0.x + b0.x, a0.y + b0.y, a1.x + b1.x, a1.y + b1.y};
            sq += (v[j].x * v[j].x + v[j].y * v[j].y) + (v[j].z * v[j].z + v[j].w * v[j].w); }
        sq = wave_sum(sq);
        const float rstd = 1.0f / sqrtf(sq * (1.0f / DM) + EPS * 1024.0f);
#pragma unroll
        for (int j = 0; j < 8; ++j) { const int col = F.lane * 4 + 256 * j; const u32x2 xb = xq[j];
            __builtin_nontemporal_store((f32x4){bf_lo(xb.x), bf_hi(xb.x), bf_lo(xb.y), bf_hi(xb.y)} + gq[j] * v[j] * rstd, (f32x4*)(out + (size_t)row * DM + col)); }
#pragma unroll
        for (int j = 0; j < 8; ++j) { ya[j] = yan[j]; yb[j] = ybn[j]; xq[j] = xqn[j]; gq[j] = gqn[j]; }
        n0 = m0; n1 = m1;
    }
#undef P10_DATA
}

__global__ void __launch_bounds__(NTHR, 2) fwd_kernel(Args args) {
    extern __shared__ __attribute__((aligned(16))) unsigned char lds[];
    Ctx F;
    F.lds = (LAS unsigned char*)lds; F.ws = args.ws; F.ctl = (unsigned*)(args.ws + WS_CTL);
    F.tid = threadIdx.x; F.lane = F.tid & 63; F.wave = __builtin_amdgcn_readfirstlane(F.tid >> 6);
    F.G = gridDim.x; F.bx = blockIdx.x; F.vcu = (F.G % 8 == 0) ? (F.bx % 8) * (F.G / 8) + F.bx / 8 : F.bx;
    const int lo = args.ph_lo, hi = args.ph_hi;
    if (F.tid < 16) ((LAS unsigned*)(F.lds + LDS_MISC))[F.tid] = 0u;
    __syncthreads();
    XcdBarrier bar; bar.bar = (unsigned*)(F.ctl + CW_BAR); bar.x = 0; bar.st = nullptr;
    if (hi - lo > 1) bar = xcd_barrier_post((unsigned*)(F.ctl + CW_BAR), (volatile LAS unsigned*)(F.lds + LDS_MISC + 32));
int rep0 = 0, rep4 = 0, rep7 = 0;
#define IN(k) (lo <= (k) && (k) < hi)
#define SEAM(k) do { if (IN(k) && IN((k) + 1)) xcd_barrier(bar); } while (0)

#ifndef DUP_PHASE
#define DUP_PHASE -1
#endif
#define RUN(k, ...) do { if (IN(k)) { __VA_ARGS__ if (DUP_PHASE == (k)) { xcd_barrier(bar); __VA_ARGS__ } } SEAM(k); } while (0)
    RUN(0, { p0_prologue(F, args, rep0++); });
    RUN(1, { p1_rows(F, args); });
    RUN(2, { SchedInProj S{(const char*)(F.ws + WS_HX), (const char*)(F.ws + WS_WIN), F.G, F.bx}; EpiInProj E{F.ws, args.in[I_QNORM], args.in[I_KNORM]};
        pg8::gemm_phase<2048, true, false, true>(F.lds, S, E); });
    RUN(4, { p4_attention(F, args, (char*)lds, rep4++); });
    RUN(5, { p5_quant_rows(F); xcd_barrier(bar);
        SchedF1 S{F.ws, F.G, F.bx}; EpiF1 E{F.ws, F.ctl};
        pg8::gemm_phase<1024, true, false, true>(F.lds, S, E); });
    RUN(6, { SchedF2 S{F.ws, F.G, F.bx}; EpiF2 E{F.ws};
        pg8::gemm_phase<2048, true, false, true>(F.lds, S, E); });
    RUN(7, { p7_router(F, args, (DUP_PHASE == 7) && (rep7++ == 0)); });
    RUN(8, { const int nu = moe_tables(F, true);
        SchedMoe S{(const LAS int*)(F.lds + TAB_UDESC), nu, (const char*)(F.ws + WS_H2), (const char*)(F.ws + WS_WGU), 0, (size_t)2048 * 2048, (size_t)256 * 2048, true}; EpiMoeUp E{F.ws, F.ctl};
        pg8::gemm_phase<2048, true, true, true>(F.lds, S, E); });
    RUN(9, { const int nu = moe_tables(F, false);
        SchedMoe S{(const LAS int*)(F.lds + TAB_UDESC), nu, (const char*)(F.ws + WS_HID), (const char*)(F.ws + WS_WDN), (size_t)256 * 1024, (size_t)2048 * 1024, (size_t)256 * 1024, false}; EpiMoeDown E{F.ws};
        pg8::gemm_phase<1024, true, false, true>(F.lds, S, E); });
    RUN(10, { p10_final(F, args); });
#undef RUN
#undef IN
#undef SEAM
}

extern "C" void kernel_launch(void* const* d_in, const int* in_sizes, int n_in, void* d_out, int out_size, void* d_ws, size_t ws_size, hipStream_t stream) {
    static int grid = 0;
    if (grid == 0) {
        if (n_in != 26 || in_sizes[0] != NTOK * DM || out_size != NTOK * DM || ws_size < WS_END2) {
            fprintf(stderr, "kernel_launch: shape/workspace mismatch: n_in %d in0 %d out %d ws %zu (need %zu)\n", n_in, n_in > 0 ? in_sizes[0] : -1, out_size, ws_size, (size_t)WS_END2); grid = -1; return; }
        int dev = 0, cus = 0, per_cu = 0;
        if (hipGetDevice(&dev) != hipSuccess || hipDeviceGetAttribute(&cus, hipDeviceAttributeMultiprocessorCount, dev) != hipSuccess) { grid = -1; return; }
        if (hipFuncSetAttribute((const void*)fwd_kernel, hipFuncAttributeMaxDynamicSharedMemorySize, LDS_BYTES) != hipSuccess) { fprintf(stderr, "kernel_launch: hipFuncSetAttribute failed\n"); grid = -1; return; }
        if (hipOccupancyMaxActiveBlocksPerMultiprocessor(&per_cu, (const void*)fwd_kernel, NTHR, LDS_BYTES) != hipSuccess || per_cu < 1)
            fprintf(stderr, "kernel_launch: occupancy query reports %d workgroups per CU\n", per_cu);
        (void)hipGetLastError();
        grid = cus;
        if (grid != 256) fprintf(stderr, "kernel_launch: note: %d CUs\n", grid);
    }
    if (grid < 0) return;
    if (hipMemsetAsync((char*)d_ws + WS_CTL, 0, CTL_ZERO_BYTES, stream) != hipSuccess) { fprintf(stderr, "kernel_launch: memset failed\n"); return; }
    Args a{};
    for (int i = 0; i < 26; ++i) a.in[i] = (const float*)d_in[i];
    a.out = (float*)d_out; a.ws = (unsigned char*)d_ws;
#if MK_N_LAUNCHES == 1
    a.ph_lo = 0; a.ph_hi = N_PHASES;
    hipLaunchKernelGGL(fwd_kernel, dim3(grid), dim3(NTHR), LDS_BYTES, stream, a);
#else
    for (int p = 0; p < N_PHASES; ++p) { a.ph_lo = p; a.ph_hi = p + 1; hipLaunchKernelGGL(fwd_kernel, dim3(grid), dim3(NTHR), LDS_BYTES, stream, a); }
#endif
    const hipError_t le = hipPeekAtLastError();
    if (le != hipSuccess) fprintf(stderr, "kernel_launch: launch failed: %s\n", hipGetErrorName(le));
}
```

```cpp
#include <hip/hip_runtime.h>
#include <cstdio>
#include <cstdint>

#define LAS __attribute__((address_space(3)))
#define GAS __attribute__((address_space(1)))
typedef unsigned short bf16_t;
typedef short bf16x8 __attribute__((ext_vector_type(8)));
typedef short s16x4 __attribute__((ext_vector_type(4)));
typedef float f32x4 __attribute__((ext_vector_type(4)));
typedef float f32x2 __attribute__((ext_vector_type(2)));
typedef float f32x16 __attribute__((ext_vector_type(16)));
typedef unsigned u32x4 __attribute__((ext_vector_type(4)));
typedef unsigned u32x2 __attribute__((ext_vector_type(2)));
typedef int i32x4 __attribute__((ext_vector_type(4)));

constexpr int NCONV8 = 3;
#ifndef MK_N_LAUNCHES
#define MK_N_LAUNCHES 1
#endif
constexpr int N_PHASES = 11;

constexpr int DM = 2048, NB = 8, SEQ = 2048, NTOK = NB * SEQ, CTXL = 256, NCTX = NB * CTXL, NROW = NTOK + NCTX, LK = CTXL + SEQ;
constexpr int NH = 8, NKV = 2, HD = 128, QW = 1024, KVW = 256, GMW = 1024, INW = 7680, NEXP = 32, DEXP = 1024, CAP = NTOK;
constexpr int NMOD = 6 * DM;
constexpr float EPS = 1e-6f;
constexpr int NWAVES = 8, NTHR = 512;

constexpr size_t MiB = 1u << 20;
constexpr size_t WS_CTL = 0, CTL_ZERO_BYTES = 65536;
constexpr size_t WS_MODP = 1 * MiB;
constexpr size_t WS_MODF = 3 * MiB;
constexpr size_t WS_ROPE = WS_MODF + 262144;
constexpr size_t WS_XSQ = WS_ROPE + 16384;
constexpr size_t WS_WRF = WS_XSQ + 65536;
constexpr size_t WS_WSB = WS_WRF + 393216;
constexpr size_t WS_SA = 4 * MiB, WS_SAH = WS_SA + 131072, WS_SBIN = WS_SAH + 131072, WS_SBGU = WS_SBIN + 262144, WS_SBDN = WS_SBGU + 262144, WS_SAHID = WS_SBDN + 262144, WS_SBWO = WS_SAHID + 262144, WS_SAMG = WS_SBWO + 65536, WS_SBBA = WS_SAMG + 65536, WS_SBBG = WS_SBBA + 8192, WS_SAATT = WS_SBBG + 8192, WS_SAGM = WS_SAATT + 65536;
constexpr size_t WS_LTOK = 6 * MiB, WS_LW = 8 * MiB, WS_TSLOT = 10 * MiB;
constexpr size_t WS_STAT = 11 * MiB;
constexpr size_t WS_XCH = 12 * MiB, WS_XCH2 = WS_XCH + (size_t)160 * 8 * 256 * 8, WS_XCH_END = WS_XCH2 + (size_t)64 * 8 * 256 * 8;
constexpr size_t WS_WIN = 20 * MiB, WS_WBA = 50 * MiB, WS_WBG = 54 * MiB, WS_WO = 58 * MiB, WS_WGU = 66 * MiB, WS_WDN = 322 * MiB;
constexpr size_t WS_ACT = 450 * MiB;
constexpr size_t WS_HX = WS_ACT, WS_H2 = WS_ACT;

constexpr size_t WS_Q = WS_ACT + 72 * MiB, WS_KRAW = WS_Q + 32 * MiB, WS_KN = WS_KRAW + 9 * MiB, WS_V = WS_KN + 9 * MiB, WS_U = WS_V + 9 * MiB, WS_VG = WS_U + 32 * MiB,
                 WS_GA = WS_VG + 32 * MiB, WS_GG = WS_GA + 64 * MiB, WS_ATT = WS_GG + 64 * MiB, WS_GM = WS_ATT + 32 * MiB, WS_MG = WS_GM + 32 * MiB, WS_MIX = WS_MG + 64 * MiB,
                 WS_END = WS_MIX + 128 * MiB;
constexpr size_t WS_HID = WS_Q, WS_Y = WS_HID + 80 * MiB;
constexpr size_t WS_ATT8 = WS_Q, WS_GM8 = WS_Q + 16 * MiB;
static_assert(WS_SAGM + 65536 <= 6 * MiB, "scale map");
constexpr size_t WS_X1 = WS_MIX + 64 * MiB;
constexpr size_t WS_MG8 = WS_END, WS_END2 = WS_END + 32 * MiB;
static_assert(WS_Y + 160 * MiB <= WS_ATT, "moe overlay");
constexpr int CW_TMO = 0, CW_BAR = 4096, CW_WORK = 8192, CW_STRIP = 8320, CW_WORK2 = 8448, CW_STRIP2 = 8512, CW_QA = 8576, CW_QB = 9088, CW_CNT = 9728, CW_XC = 13824, CW_XC2 = 12800, CW_STRIP3 = 12672;

constexpr int RING_BYTES = 131072;
constexpr int LDS_MISC = 163840 - 64;
constexpr int LDS_TAB = RING_BYTES + 64;
constexpr int MAXU = 6;
constexpr int TAB_ROWOFF = LDS_TAB;
constexpr int TAB_W = TAB_ROWOFF + MAXU * 1024;
constexpr int TAB_SA = TAB_W + MAXU * 1024;
constexpr int TAB_UDESC = TAB_SA + MAXU * 1024;
constexpr int TAB_CNT = TAB_UDESC + MAXU * 16 + 32;
constexpr int TAB_TBASE = TAB_CNT + 128;
constexpr int TAB_TILEE = TAB_TBASE + 144;
constexpr int XCH_M = 151552, XCH_R = 155648;
constexpr int PRE_OFF = 156672;
constexpr int LDS_BYTES = 163840;
static_assert(TAB_TILEE + 640 <= LDS_MISC, "lds map");

#define RLX_AGENT __ATOMIC_RELAXED, __HIP_MEMORY_SCOPE_AGENT
#define LDS_WAIT() asm volatile("s_waitcnt lgkmcnt(0)" ::: "memory")
#define VM_WAIT() asm volatile("s_waitcnt vmcnt(0)" ::: "memory")
__device__ __forceinline__ unsigned cvt_pk_bf16(float lo, float hi) { unsigned r; asm volatile("v_cvt_pk_bf16_f32 %0, %1, %2" : "=v"(r) : "v"(lo), "v"(hi)); return r; }
__device__ __forceinline__ float bf_lo(unsigned w) { return __uint_as_float(w << 16); }
__device__ __forceinline__ float bf_hi(unsigned w) { return __uint_as_float(w & 0xffff0000u); }
__device__ __forceinline__ float bf1(bf16_t h) { return __uint_as_float(((unsigned)h) << 16); }
__device__ __forceinline__ float fexp2(float x) { return __builtin_amdgcn_exp2f(x); }
__device__ __forceinline__ float frcp(float x) { return __builtin_amdgcn_rcpf(x); }
__device__ __forceinline__ float sigmoidf_(float x) { return frcp(1.0f + fexp2(-1.4426950408889634f * x)); }
__device__ __forceinline__ float siluf_(float x) { return x * sigmoidf_(x); }
__device__ __forceinline__ float gelu_tanh(float x) { const float u = x * (1.0f + 0.044715f * x * x); return x * frcp(1.0f + fexp2(-2.302208198f * u)); }
__device__ __forceinline__ unsigned q8x4(f32x4 v) {
    const int a = (int)rintf(v.x), b = (int)rintf(v.y), c = (int)rintf(v.z), d = (int)rintf(v.w);
    return ((unsigned)a & 0xffu) | (((unsigned)b & 0xffu) << 8) | (((unsigned)c & 0xffu) << 16) | ((unsigned)d << 24); }
__device__ __forceinline__ unsigned q8x4m(f32x4 v, float sc) {
    const unsigned t0 = __float_as_uint(fmaf(v.x, sc, 12582912.0f)), t1 = __float_as_uint(fmaf(v.y, sc, 12582912.0f)), t2 = __float_as_uint(fmaf(v.z, sc, 12582912.0f)), t3 = __float_as_uint(fmaf(v.w, sc, 12582912.0f));
    return __builtin_amdgcn_perm(t1, t0, 0x0c0c0400u) | __builtin_amdgcn_perm(t3, t2, 0x04000c0cu); }
template <int CTRL> __device__ __forceinline__ float dppf(float v) { return __int_as_float(__builtin_amdgcn_update_dpp(0, __float_as_int(v), CTRL, 0xf, 0xf, true)); }
__device__ __forceinline__ float psum16(float v) { auto r = __builtin_amdgcn_permlane16_swap(__float_as_uint(v), __float_as_uint(v), false, false); return __uint_as_float(r[0]) + __uint_as_float(r[1]); }
__device__ __forceinline__ float psum32(float v) { auto r = __builtin_amdgcn_permlane32_swap(__float_as_uint(v), __float_as_uint(v), false, false); return __uint_as_float(r[0]) + __uint_as_float(r[1]); }
__device__ __forceinline__ float pmax16(float v) { auto r = __builtin_amdgcn_permlane16_swap(__float_as_uint(v), __float_as_uint(v), false, false); return fmaxf(__uint_as_float(r[0]), __uint_as_float(r[1])); }
__device__ __forceinline__ float pmax32(float v) { auto r = __builtin_amdgcn_permlane32_swap(__float_as_uint(v), __float_as_uint(v), false, false); return fmaxf(__uint_as_float(r[0]), __uint_as_float(r[1])); }
__device__ __forceinline__ float wave_sum(float v) {
    v += dppf<0xB1>(v); v += dppf<0x4E>(v); v += dppf<0x141>(v); v += dppf<0x140>(v);
    return psum32(psum16(v));
}
__device__ __forceinline__ float wave_max(float v) {
    v = fmaxf(v, dppf<0xB1>(v)); v = fmaxf(v, dppf<0x4E>(v)); v = fmaxf(v, dppf<0x141>(v)); v = fmaxf(v, dppf<0x140>(v));
    return pmax32(pmax16(v));
}

#define XB_TMO      128
#define XB_XCNT(j)  (256  + 64 * (j))
#define XB_XSUB(j)  (1280 + 64 * (j))
#define XB_XGEN(j)  (2304 + 64 * (j))
#define XB_TOP      3328
#define XB_TOPGEN   3392
#define XCD_BAR_WORDS 3456
#define XB_SPIN_CAP (1u << 18)
__device__ __forceinline__ unsigned xb_ld(unsigned* p)              { return __hip_atomic_load(p, __ATOMIC_RELAXED, __HIP_MEMORY_SCOPE_AGENT); }
__device__ __forceinline__ unsigned xb_add(unsigned* p, unsigned v) { return __hip_atomic_fetch_add(p, v, __ATOMIC_RELAXED, __HIP_MEMORY_SCOPE_AGENT); }
__device__ __forceinline__ unsigned xb_xcc_id() { return (unsigned)__builtin_amdgcn_s_getreg((3 << 11) | 20) & 0xFu; }
#define XB_SPIN(cond, bar) do { unsigned _sp = 0; while (cond) { __builtin_amdgcn_s_sleep(1); \
    if ((++_sp & 255u) == 0u) { if (xb_ld(&(bar)[XB_TMO])) break; if (_sp > XB_SPIN_CAP) { atomicAdd(&(bar)[XB_TMO], 1u); break; } } } } while (0)
struct XcdBarrier { unsigned* bar; unsigned x; volatile LAS unsigned* st; };
__device__ __forceinline__ XcdBarrier xcd_barrier_post(unsigned* bar, volatile LAS unsigned* st) {
    XcdBarrier b; b.bar = bar; b.x = xb_xcc_id(); b.st = st;
    if (threadIdx.x == 0) (void)xb_add(&bar[XB_XCNT(b.x)], 1u);
    return b;
}
__device__ __forceinline__ void xcd_barrier_complete(unsigned* bar, unsigned x, unsigned& nloc, unsigned& nx) {
    const unsigned G = gridDim.x * gridDim.y * gridDim.z;
    unsigned sum, cnt, mine, sp = 0u;
    for (;;) {
        sum = 0u; cnt = 0u; mine = 0u;
#pragma unroll
        for (unsigned j = 0; j < 16; ++j) { const unsigned c = xb_ld(&bar[XB_XCNT(j)]); sum += c; cnt += (c > 0u) ? 1u : 0u; mine = (j == x) ? c : mine; }
        if (sum == G) break;
        __builtin_amdgcn_s_sleep(1);
        if ((++sp & 255u) == 0u) { if (xb_ld(&bar[XB_TMO])) break; if (sp > XB_SPIN_CAP) { atomicAdd(&bar[XB_TMO], 1u); break; } }
    }
    nloc = mine > 0u ? mine : 1u; nx = cnt > 0u ? cnt : 1u;
}
__device__ __forceinline__ void xcd_barrier(const XcdBarrier& b) {
    asm volatile("s_waitcnt vmcnt(0)" ::: "memory");
    __syncthreads();
    if (threadIdx.x == 0) {
        unsigned* bar = b.bar;
        __builtin_amdgcn_s_waitcnt(0);
        unsigned nloc = b.st[0], nx = b.st[1];
        if (nloc == 0u) { xcd_barrier_complete(bar, b.x, nloc, nx); b.st[0] = nloc; b.st[1] = nx; }
        const unsigned old = xb_add(&bar[XB_XSUB(b.x)], 1u);
        const unsigned gen = old / nloc;
        if (old + 1u == (gen + 1u) * nloc) {
            __builtin_amdgcn_fence(__ATOMIC_RELEASE, "agent");
            asm volatile("s_waitcnt vmcnt(0)" ::: "memory");
            const unsigned og = xb_add(&bar[XB_TOP], 1u);
            const unsigned tg = og / nx;
            if (og + 1u == (tg + 1u) * nx) xb_add(&bar[XB_TOPGEN], 1u);
            else XB_SPIN(xb_ld(&bar[XB_TOPGEN]) == tg, bar);
            __builtin_amdgcn_fence(__ATOMIC_ACQUIRE, "agent");
            xb_add(&bar[XB_XGEN(b.x)], 1u);
            asm volatile("s_waitcnt vmcnt(0)" ::: "memory");
        } else {
            XB_SPIN(xb_ld(&bar[XB_XGEN(b.x)]) == gen, bar);
            __builtin_amdgcn_fence(__ATOMIC_ACQUIRE, "agent");
            asm volatile("s_waitcnt vmcnt(0)" ::: "memory");
        }
    }
    __syncthreads();
}

namespace pg8 {
constexpr int BM = 256, BK = 64, HALF = 128, HTB = HALF * BK * 2, STAGE_BYTES = 8 * HTB, NXCD = 8, WGM = 8;
__device__ __forceinline__ int lds_byte(int r, int c) { const int st = (r >> 4) * 2 + (c >> 5), rr = r & 15, cc = c & 31, ob = rr * 64 + cc * 2; return st * 1024 + (ob ^ (((ob >> 9) & 1) << 5)); }
__device__ __forceinline__ void stage_rc(int b, int& R, int& C) { const int st = b / 1024, sb = b % 1024, swz = sb ^ (((sb >> 9) & 1) << 5); R = (st >> 1) * 16 + swz / 64; C = (st & 1) * 32 + (swz % 64) / 2; }
__device__ __forceinline__ int perm32(int rho) { const int n = rho >> 4, i = rho & 15; return 8 * (i >> 2) + 4 * n + (i & 3); }

struct Unit { const char* a; const char* b; int pm, pn, e, slot; };

__device__ __forceinline__ void static_map(int L, int nM, int nN, int& pm, int& pn) {
    const int nwg = nM * nN; int wgid = L;
    { const int q = nwg / NXCD, r = nwg % NXCD, xcd = wgid % NXCD, off = wgid / NXCD; wgid = (xcd < r ? xcd * (q + 1) : r * (q + 1) + (xcd - r) * q) + off; }
    const int nig = WGM * nN, gid = wgid / nig, fm = gid * WGM, gsz = (nM - fm) < WGM ? (nM - fm) : WGM;
    pm = fm + ((wgid % nig) % gsz); pn = (wgid % nig) / gsz;
}

template <bool I8> struct AccSel { typedef f32x4 T; };
template <> struct AccSel<true> { typedef i32x4 T; };
template <int ROWB, bool I8, bool GATHER, bool ALIGN_EPI, class Epi, class Sched>
__device__ __forceinline__ void gemm_phase(LAS unsigned char* lds, const Sched& S, const Epi& E) {
    const int tid = threadIdx.x, wid = __builtin_amdgcn_readfirstlane(tid >> 6), lane = tid & 63, wr = wid >> 2, wc = wid & 3, fr = lane & 15, fq = lane >> 4;
    constexpr int nt = ROWB / 128;
    typedef typename AccSel<I8>::T acc_t;
    unsigned voffA[2], voffB[2]; int rowA[2];
#pragma unroll
    for (int i = 0; i < 2; ++i) { int R, C; stage_rc(tid * 16 + i * 8192, R, C); const int Rb = Epi::PERM ? ((R & ~31) + perm32(R & 31)) : R;
        voffA[i] = GATHER ? (unsigned)(C * 2) : (unsigned)(R * ROWB + C * 2); voffB[i] = (unsigned)(Rb * ROWB + C * 2); rowA[i] = R; }
    constexpr size_t kstep = (size_t)(BK * 2);
    constexpr size_t hstep = (size_t)HALF * ROWB;
    const unsigned ldsw = (unsigned)wid * 1024u;
    const int aoff = lds_byte(wr * 64 + fr, fq * 8), boff = lds_byte(wc * 32 + fr, fq * 8);
    const LAS unsigned* rowtab = (const LAS unsigned*)(lds + (TAB_ROWOFF - 0));
#define PG8_SA(b, h) (((b) * 2 + (h)) * HTB)
#define PG8_SB(b, h) ((4 + (b) * 2 + (h)) * HTB)
#define PG8_GLDS(src, bufoff, i) __builtin_amdgcn_global_load_lds((const unsigned*)(src), (LAS unsigned*)(lds + (bufoff) + ldsw + (i) * 8192), 16, 0, 0)
#define PG8_STAGE_B(bufoff, gbase) do { PG8_GLDS((const char*)(gbase) + voffB[0], bufoff, 0); PG8_GLDS((const char*)(gbase) + voffB[1], bufoff, 1); } while (0)
#define PG8_STAGE_A(bufoff, gbase, h, g0, g1) do { if constexpr (GATHER) { PG8_GLDS((const char*)(gbase) + (g0) + voffA[0], bufoff, 0); PG8_GLDS((const char*)(gbase) + (g1) + voffA[1], bufoff, 1); } \
        else { PG8_GLDS((const char*)(gbase) + (h) * hstep + voffA[0], bufoff, 0); PG8_GLDS((const char*)(gbase) + (h) * hstep + voffA[1], bufoff, 1); } } while (0)
#define PG8_LDA(dst, b, h) do { _Pragma("unroll") for (int m = 0; m < 4; ++m) _Pragma("unroll") for (int k = 0; k < 2; ++k) dst[m][k] = *(const LAS bf16x8*)(lds + PG8_SA(b, h) + aoff + m * 2048 + k * 1024); } while (0)
#define PG8_LDB(dst, b, h) do { _Pragma("unroll") for (int n = 0; n < 2; ++n) _Pragma("unroll") for (int k = 0; k < 2; ++k) dst[n][k] = *(const LAS bf16x8*)(lds + PG8_SB(b, h) + boff + n * 2048 + k * 1024); } while (0)
#define PG8_MMA(ai, bj, At, Bt) do { __builtin_amdgcn_s_setprio(1); _Pragma("unroll") for (int m = 0; m < 4; ++m) _Pragma("unroll") for (int n = 0; n < 2; ++n) _Pragma("unroll") for (int k = 0; k < 2; ++k) { \
        if constexpr (I8) acc[ai][bj][m][n] = __builtin_amdgcn_mfma_i32_16x16x64_i8(__builtin_bit_cast(i32x4, Bt[n][k]), __builtin_bit_cast(i32x4, At[m][k]), acc[ai][bj][m][n], 0, 0, 0); \
        else acc[ai][bj][m][n] = __builtin_amdgcn_mfma_f32_16x16x32_bf16(Bt[n][k], At[m][k], acc[ai][bj][m][n], 0, 0, 0); } __builtin_amdgcn_s_setprio(0); } while (0)
#define PG8_WAIT_V(n) asm volatile("s_waitcnt vmcnt(" #n ")" ::: "memory")
#define PG8_WAIT_L(n) asm volatile("s_waitcnt lgkmcnt(" #n ")" ::: "memory")
#define PG8_BAR __builtin_amdgcn_s_barrier()
#define PG8_SCHED __builtin_amdgcn_sched_barrier(0)
    Unit cur, nxt; int ui = 0;
    if (!S.next(0, cur)) return;
    float pre_a = 0.f, pre_b = 0.f;
#define PG8_PRE(U) do { if constexpr (Epi::PRE) { if (tid < 256) { const float* pa_; const float* pb_; E.pre_addr(U, tid, pa_, pb_); pre_a = *pa_; pre_b = *pb_; } } } while (0)
    PG8_PRE(cur);
    acc_t acc[2][2][4][2];
#pragma unroll
    for (int a = 0; a < 2; ++a)
#pragma unroll
        for (int b = 0; b < 2; ++b)
#pragma unroll
            for (int m = 0; m < 4; ++m)
#pragma unroll
                for (int n = 0; n < 2; ++n) acc[a][b][m][n] = (acc_t){0, 0, 0, 0};
    bf16x8 At[4][2], B0[2][2], B1[2][2];
    const char* cA = cur.a; const char* cB = cur.b;
    unsigned g00 = 0, g01 = 0, g10 = 0, g11 = 0;
    if constexpr (GATHER) { const LAS unsigned* rt = rowtab + cur.slot * 256; g00 = rt[rowA[0]]; g01 = rt[rowA[1]]; g10 = rt[128 + rowA[0]]; g11 = rt[128 + rowA[1]]; }
    PG8_STAGE_B(PG8_SB(0, 0), cB); PG8_STAGE_B(PG8_SB(0, 1), cB + hstep); PG8_STAGE_A(PG8_SA(0, 0), cA, 0, g00, g01); PG8_STAGE_A(PG8_SA(0, 1), cA, 1, g10, g11);
    if (wr == 1) PG8_BAR;
    PG8_WAIT_V(2); PG8_BAR;
    PG8_STAGE_B(PG8_SB(1, 0), cB + kstep); PG8_STAGE_A(PG8_SA(1, 0), cA + kstep, 0, g00, g01); PG8_STAGE_B(PG8_SB(1, 1), cB + hstep + kstep);
    PG8_WAIT_V(6); PG8_BAR;
    for (;;) {
        const bool has_next = S.next(ui + 1, nxt);
        const char* nA = has_next ? nxt.a : cA; const char* nB = has_next ? nxt.b : cB;
        for (int t = 0; t < nt; t += 2) {
            const bool last = (t == nt - 2);
            const char* a1 = cA + (size_t)(t + 1) * kstep;
            const char* a2 = last ? nA : cA + (size_t)(t + 2) * kstep; const char* b2 = last ? nB : cB + (size_t)(t + 2) * kstep;
            const char* a3 = a2 + kstep; const char* b3 = b2 + kstep;
            unsigned n00 = g00, n01 = g01, n10 = g10, n11 = g11;
            if constexpr (GATHER) { if (last && has_next) { const LAS unsigned* rt = rowtab + nxt.slot * 256; n00 = rt[rowA[0]]; n01 = rt[rowA[1]]; n10 = rt[128 + rowA[0]]; n11 = rt[128 + rowA[1]]; } }
            PG8_LDB(B0, 0, 0); PG8_LDB(B1, 0, 1); PG8_SCHED; PG8_LDA(At, 0, 0); PG8_STAGE_A(PG8_SA(1, 1), a1, 1, g10, g11);
            PG8_WAIT_V(8); PG8_WAIT_L(0); PG8_BAR; PG8_MMA(0, 0, At, B0); PG8_MMA(0, 1, At, B1); PG8_BAR; PG8_SCHED;
            PG8_LDA(At, 0, 1); PG8_STAGE_B(PG8_SB(0, 0), b2); PG8_STAGE_B(PG8_SB(0, 1), b2 + hstep); PG8_STAGE_A(PG8_SA(0, 0), a2, 0, n00, n01);
            PG8_WAIT_V(8); PG8_WAIT_L(0); PG8_BAR; PG8_MMA(1, 0, At, B0); PG8_MMA(1, 1, At, B1); PG8_BAR; PG8_SCHED;
            PG8_LDB(B0, 1, 0); PG8_LDB(B1, 1, 1); PG8_SCHED; PG8_LDA(At, 1, 0); PG8_STAGE_A(PG8_SA(0, 1), a2, 1, n10, n11);
            PG8_WAIT_V(8); PG8_WAIT_L(0); PG8_BAR; PG8_MMA(0, 0, At, B0); PG8_MMA(0, 1, At, B1); PG8_BAR; PG8_SCHED;
            PG8_LDA(At, 1, 1); PG8_STAGE_B(PG8_SB(1, 0), b3); PG8_STAGE_B(PG8_SB(1, 1), b3 + hstep); PG8_STAGE_A(PG8_SA(1, 0), a3, 0, n00, n01);
            PG8_WAIT_V(8); PG8_WAIT_L(0); PG8_BAR; PG8_MMA(1, 0, At, B0); PG8_MMA(1, 1, At, B1); PG8_BAR; PG8_SCHED;
            if constexpr (GATHER) { if (last) { g00 = n00; g01 = n01; g10 = n10; g11 = n11; } }
        }
        if constexpr (ALIGN_EPI) { if (wr == 0) PG8_BAR; }
        { int tz = threadIdx.x; asm volatile("" : "+v"(tz));
          if constexpr (Epi::PRE) { LAS float* pt = (LAS float*)(lds + PRE_OFF); if (tz < 256) { pt[tz] = pre_a; pt[256 + tz] = pre_b; }
              asm volatile("s_waitcnt lgkmcnt(0)" ::: "memory"); __builtin_amdgcn_s_barrier(); asm volatile("" ::: "memory"); }
          const int ew = tz >> 6, el = tz & 63; E(acc, cur, ew >> 2, ew & 3, el & 15, el >> 4, lds); }
        if (!has_next) break;
        PG8_PRE(nxt);
#pragma unroll
        for (int a = 0; a < 2; ++a)
#pragma unroll
            for (int b = 0; b < 2; ++b)
#pragma unroll
                for (int m = 0; m < 4; ++m)
#pragma unroll
                    for (int n = 0; n < 2; ++n) acc[a][b][m][n] = (acc_t){0, 0, 0, 0};
        cur = nxt; cA = nA; cB = nB; ++ui;
        if constexpr (ALIGN_EPI) { if (wr == 1) PG8_BAR; }
    }
    PG8_WAIT_V(0);
    if constexpr (!ALIGN_EPI) { if (wr == 0) PG8_BAR; }
    PG8_BAR;
#undef PG8_SA
#undef PG8_SB
#undef PG8_GLDS
#undef PG8_STAGE_A
#undef PG8_STAGE_B
#undef PG8_LDA
#undef PG8_LDB
#undef PG8_MMA
#undef PG8_WAIT_V
#undef PG8_WAIT_L
#undef PG8_BAR
#undef PG8_SCHED
#undef PG8_PRE
}
}

struct Args { const float* in[26]; float* out; unsigned char* ws; int ph_lo, ph_hi; };
enum { I_X = 0, I_C, I_CTX, I_CCTX, I_WADA, I_BADA, I_GPRE1, I_GPOST1, I_GPRE2, I_GPOST2, I_WIN, I_QNORM, I_KNORM, I_GMLN, I_WS, I_BS, I_WBA, I_WBG, I_WO, I_WRG, I_BRG, I_WRE, I_BRE, I_WGATE, I_WUP, I_WDOWN };

struct Ctx {
    LAS unsigned char* lds; unsigned char* ws; unsigned* ctl;
    int tid, lane, wave, G, bx, vcu;
};

__device__ __forceinline__ void item_load(const float* W, int N, int k0, int n0, int lane, float (&tv)[32]) {
#pragma unroll
    for (int i = 0; i < 32; ++i) { const int kk = 2 * i + (lane >> 5); tv[i] = __builtin_nontemporal_load(&W[(size_t)(k0 + kk) * N + n0 + (lane & 31)]); }
}
__device__ __forceinline__ void item_store(const float (&tv)[32], int K, bf16_t* WT, int k0, int drow0, LAS float* scr, int lane) {
#pragma unroll
    for (int i = 0; i < 32; ++i) { const int kk = 2 * i + (lane >> 5); scr[kk * 33 + (lane & 31)] = tv[i]; }
    LDS_WAIT(); asm volatile("" ::: "memory");
    const int c = lane & 7;
#pragma unroll
    for (int j = 0; j < 4; ++j) { const int n = (lane >> 3) + 8 * j; const LAS float* s = scr + (8 * c) * 33 + n;
        u32x4 o; o.x = cvt_pk_bf16(s[0 * 33], s[1 * 33]); o.y = cvt_pk_bf16(s[2 * 33], s[3 * 33]); o.z = cvt_pk_bf16(s[4 * 33], s[5 * 33]); o.w = cvt_pk_bf16(s[6 * 33], s[7 * 33]);
        *(u32x4*)(WT + (size_t)(drow0 + n) * K + k0 + 8 * c) = o; }
    LDS_WAIT(); asm volatile("" ::: "memory");
}
constexpr int IT_WBA = 16 * 64, IT_WO = 32 * 64, IT_DN = 16 * 64;
constexpr int CHUNK_ITEMS = 8, N_CHUNKS_SMALL = (2 * IT_WBA) / CHUNK_ITEMS, N_CHUNKS_DN = NEXP * IT_DN / CHUNK_ITEMS;
constexpr int NSTRIPS_IN = 240, NSTRIPS_GU = NEXP * 64, NSTRIPS_DN = NEXP * 64, NSTRIPS_WO = 64, NSTRIPS_BR = 128;

__device__ __forceinline__ int strip_rowmap(int i, int mode) { return mode ? (32 * (i >> 4) + 8 * ((i >> 2) & 3) + 4 * (mode - 1) + (i & 3)) : i; }
template <int NH> __device__ __forceinline__ void strip_load_half(const Ctx& F, const float* src, int N, int h, f32x4 (&v)[16]) {
    const int c4 = F.lane & 7, rs = F.lane >> 3;
    const GAS float* p = (const GAS float*)(src + (size_t)(h * (64 * NH) + F.wave * (8 * NH) + rs) * N + c4 * 4); const size_t step = (size_t)8 * N;
#pragma unroll
    for (int i = 0; i < NH; ++i) { v[i] = __builtin_nontemporal_load((const GAS f32x4*)p); p += step; asm volatile("" : "+v"(p)); }
}
constexpr int STRIP_TAB = LDS_TAB + 2048;
template <int NH> __device__ __forceinline__ void strip_phase1_half(const Ctx& F, const f32x4 (&v)[16], int h, float (&cm)[4]) {
    const int c4 = F.lane & 7, rs = F.lane >> 3;
    const int k0 = h * (64 * NH) + F.wave * (8 * NH);
    LAS unsigned char* base = F.lds + (k0 + rs) * 64 + (k0 >> 4) * 8 + c4 * 8;
#pragma unroll
    for (int i = 0; i < NH; ++i) {
        cm[0] = fmaxf(cm[0], fabsf(v[i].x)); cm[1] = fmaxf(cm[1], fabsf(v[i].y)); cm[2] = fmaxf(cm[2], fabsf(v[i].z)); cm[3] = fmaxf(cm[3], fabsf(v[i].w));
        *(LAS u32x2*)(base + i * 512 + (i >> 1) * 8) = (u32x2){cvt_pk_bf16(v[i].x, v[i].y), cvt_pk_bf16(v[i].z, v[i].w)}; }
}
__device__ __forceinline__ void strip_phase1_finish(const Ctx& F, float (&cm)[4], float* sc, int mode, unsigned nx) {
    LAS float* cmtab = (LAS float*)(F.lds + STRIP_TAB); LAS float* sctab = cmtab + 256;
    const int c4 = F.lane & 7, rs = F.lane >> 3;
#pragma unroll
    for (int e = 0; e < 4; ++e) { cm[e] = fmaxf(cm[e], dppf<0x128>(cm[e])); cm[e] = pmax32(pmax16(cm[e])); }
    if (rs == 0) {
#pragma unroll
        for (int e = 0; e < 4; ++e) cmtab[F.wave * 32 + c4 * 4 + e] = cm[e]; }
    if (F.tid == 0) ((LAS unsigned*)(F.lds + LDS_MISC))[0] = nx;
    __syncthreads();
    if (F.tid < 32) { float m = 1e-30f;
#pragma unroll
        for (int w = 0; w < 8; ++w) m = fmaxf(m, cmtab[w * 32 + F.tid]);
        sctab[F.tid] = 127.0f / m; sc[strip_rowmap(F.tid, mode)] = m * (1.0f / 127.0f); }
    __syncthreads();
}
template <int NI, bool NT> __device__ __forceinline__ void strip_phase2(const Ctx& F, signed char* dst, int mode) {
    const LAS float* sctab = (const LAS float*)(F.lds + STRIP_TAB) + 256;
    constexpr int KC = 4 * NI, K = 64 * NI;
#pragma unroll 1
    for (int i = 0; i < KC / 64; ++i) { const int bb = F.tid + 512 * i, kc = bb & (KC - 1), cg = bb / KC;
        const f32x4 inv = *(const LAS f32x4*)(sctab + cg * 4);
        const LAS unsigned char* rp = F.lds + kc * (1024 + 8) + cg * 8;
        u32x4 o[4];
        u32x2 w[2][4];
#pragma unroll
        for (int jj = 0; jj < 4; ++jj) w[0][jj] = *(const LAS u32x2*)(rp + jj * 64);
#pragma unroll
        for (int d = 0; d < 4; ++d) { unsigned t[4][4];
            if (d < 3) {
#pragma unroll
                for (int jj = 0; jj < 4; ++jj) w[(d + 1) & 1][jj] = *(const LAS u32x2*)(rp + ((d + 1) * 4 + jj) * 64); }
            __builtin_amdgcn_sched_barrier(0);
#pragma unroll
            for (int jj = 0; jj < 4; ++jj) { const u32x2 ww = w[d & 1][jj];
                t[0][jj] = __float_as_uint(fmaf(bf_lo(ww.x), inv.x, 12582912.0f)); t[1][jj] = __float_as_uint(fmaf(bf_hi(ww.x), inv.y, 12582912.0f));
                t[2][jj] = __float_as_uint(fmaf(bf_lo(ww.y), inv.z, 12582912.0f)); t[3][jj] = __float_as_uint(fmaf(bf_hi(ww.y), inv.w, 12582912.0f)); }
#pragma unroll
            for (int e = 0; e < 4; ++e) o[e][d] = __builtin_amdgcn_perm(t[e][1], t[e][0], 0x0c0c0400u) | __builtin_amdgcn_perm(t[e][3], t[e][2], 0x04000c0cu);
            __builtin_amdgcn_sched_barrier(0); }
#pragma unroll
        for (int e = 0; e < 4; ++e) { u32x4* dp = (u32x4*)(dst + (size_t)strip_rowmap(cg * 4 + e, mode) * K + kc * 16); if constexpr (NT) __builtin_nontemporal_store(o[e], dp); else *dp = o[e]; } }
    __syncthreads();
}
__device__ __forceinline__ void strip_decode(const Ctx& F, const Args& A, int sid, int kind, const float*& src, int& N, signed char*& dst, float*& sc, int& mode) {
    mode = 0;
    if (kind == 0) { const int n0 = sid * 32, pn = n0 >> 8; int base = n0;
        if (pn == 0 || (pn >= 2 && pn < 6)) { const int hc = n0 & 127; mode = 1 + ((hc >> 5) & 1); base = (n0 & ~127) + 64 * (hc >> 6); }
        src = A.in[I_WIN] + n0; N = INW; dst = (signed char*)(F.ws + WS_WIN) + (size_t)base * 2048; sc = (float*)(F.ws + WS_SBIN) + base; }
    else if (kind == 1) { const int e = sid >> 6, q = sid & 63, up = q >> 5, n0 = (q & 31) * 32, drow0 = (n0 >> 7) * 256 + (n0 & 127) + up * 128;
        src = (up ? A.in[I_WUP] : A.in[I_WGATE]) + (size_t)e * 2048 * 1024 + n0; N = 1024; dst = (signed char*)(F.ws + WS_WGU) + (size_t)e * 2048 * 2048 + (size_t)drow0 * 2048; sc = (float*)(F.ws + WS_SBGU) + e * 2048 + drow0; }
    else if (kind == 4) { const int g = sid >> 6, n0 = (sid & 63) * 32;
        src = (g ? A.in[I_WBG] : A.in[I_WBA]) + n0; N = 2048; dst = (signed char*)(F.ws + (g ? WS_WBG : WS_WBA)) + (size_t)n0 * 1024; sc = (float*)(F.ws + (g ? WS_SBBG : WS_SBBA)) + n0; }
    else if (kind == 3) { const int n0 = sid * 32; src = A.in[I_WO] + n0; N = 2048; dst = (signed char*)(F.ws + WS_WO) + (size_t)n0 * 2048; sc = (float*)(F.ws + WS_SBWO) + n0; }
    else { const int e = sid >> 6, n0 = (sid & 63) * 32;
        src = A.in[I_WDOWN] + (size_t)e * 1024 * 2048 + n0; N = 2048; dst = (signed char*)(F.ws + WS_WDN) + (size_t)e * 2048 * 1024 + (size_t)n0 * 1024; sc = (float*)(F.ws + WS_SBDN) + e * 2048 + n0; }
}

__device__ __forceinline__ int wg_grab(const Ctx& F, unsigned* counter) {
    LAS unsigned* bw = (LAS unsigned*)(F.lds + LDS_MISC);
    if (F.tid == 0) bw[0] = __hip_atomic_fetch_add(counter, 1u, RLX_AGENT);
    __syncthreads();
    const int v = __builtin_amdgcn_readfirstlane((int)bw[0]);
    __syncthreads();
    return v;
}
template <int KIND> __device__ __forceinline__ void convert_strips(const Ctx& F, const Args& A, unsigned* counter) {
    constexpr int NS = KIND == 0 ? NSTRIPS_IN : (KIND == 1 ? NSTRIPS_GU : (KIND == 2 ? NSTRIPS_DN : (KIND == 3 ? NSTRIPS_WO : NSTRIPS_BR))), NH = (KIND == 2 || KIND == 4) ? 8 : 16;
    int sid = wg_grab(F, counter); if (sid >= NS) return;
    int nsid = wg_grab(F, counter);
    const float* src; int N; signed char* dst; float* sc; int mode;
    strip_decode(F, A, sid, KIND, src, N, dst, sc, mode);
    f32x4 va[16], vb[16]; strip_load_half<NH>(F, src, N, 0, va); strip_load_half<NH>(F, src, N, 1, vb);
    unsigned nx = 0; if (F.tid == 0) nx = __hip_atomic_fetch_add(counter, 1u, RLX_AGENT);
    float cm[4];
    for (;;) {
        signed char* cdst = dst; float* csc = sc; const int cmode = mode;
        cm[0] = cm[1] = cm[2] = cm[3] = 0.f;
        strip_phase1_half<NH>(F, va, 0, cm);
        if (nsid >= NS) break;
        strip_decode(F, A, nsid, KIND, src, N, dst, sc, mode); strip_load_half<NH>(F, src, N, 0, va);
        strip_phase1_half<NH>(F, vb, 1, cm);
        strip_load_half<NH>(F, src, N, 1, vb);
        strip_phase1_finish(F, cm, csc, cmode, nx);
        nsid = __builtin_amdgcn_readfirstlane((int)((const LAS unsigned*)(F.lds + LDS_MISC))[0]);
        if (F.tid == 0) nx = __hip_atomic_fetch_add(counter, 1u, RLX_AGENT);
        strip_phase2<2 * NH, (KIND == 1 || KIND == 2)>(F, cdst, cmode);
    }
    strip_phase1_half<NH>(F, vb, 1, cm);
    strip_phase1_finish(F, cm, sc, mode, nx);
    strip_phase2<2 * NH, (KIND == 1 || KIND == 2)>(F, dst, mode);
}
__device__ __forceinline__ void item_decode(const Ctx& F, const Args& A, int r, bool moe, const float*& W, bf16_t*& WT, int& K, int& N, int& k0, int& n0) {
    if (moe) { const int e = r / IT_DN; r -= e * IT_DN; W = A.in[I_WDOWN] + (size_t)e * 1024 * 2048; WT = (bf16_t*)(F.ws + WS_WDN) + (size_t)e * 2048 * 1024; K = 1024; N = 2048; }
    else if (r < IT_WBA) { W = A.in[I_WBA]; WT = (bf16_t*)(F.ws + WS_WBA); K = 1024; N = 2048; }
    else { r -= IT_WBA; W = A.in[I_WBG]; WT = (bf16_t*)(F.ws + WS_WBG); K = 1024; N = 2048; }
    const int nblk = N >> 5, kb = r / nblk, nb = r - kb * nblk; k0 = kb * 64; n0 = nb * 32;
}
__device__ __forceinline__ unsigned wave_grab(const Ctx& F, unsigned* counter) {
    unsigned ch = 0; if (F.lane == 0) ch = __hip_atomic_fetch_add(counter, 1u, RLX_AGENT);
    return (unsigned)__builtin_amdgcn_readfirstlane((int)ch);
}
__device__ __forceinline__ void convert_items(const Ctx& F, const Args& A, unsigned* counter, bool moe) {
    LAS float* scr = (LAS float*)(F.lds + F.wave * 16384);
    const unsigned NC = (unsigned)(moe ? N_CHUNKS_DN : N_CHUNKS_SMALL);
    for (;;) {
        const unsigned ch = wave_grab(F, counter); if (ch >= NC) break;
        for (int q = 0; q < CHUNK_ITEMS; q += 2) {
            const float* W0; bf16_t* WT0; int K0, N0, k00, n00; const float* W1; bf16_t* WT1; int K1, N1, k01, n01;
            item_decode(F, A, (int)ch * CHUNK_ITEMS + q, moe, W0, WT0, K0, N0, k00, n00);
            item_decode(F, A, (int)ch * CHUNK_ITEMS + q + 1, moe, W1, WT1, K1, N1, k01, n01);
            float ta[32], tb[32]; item_load(W0, N0, k00, n00, F.lane, ta); item_load(W1, N1, k01, n01, F.lane, tb);
            item_store(ta, K0, WT0, k00, n00, scr, F.lane);
            item_store(tb, K1, WT1, k01, n01, scr, F.lane);
        }
    }
}

__device__ __forceinline__ void p0_prologue(const Ctx& F, const Args& A, int rep) {
    { u32x4* xz = (u32x4*)(F.ws + WS_XCH); constexpr int NZ = (int)((WS_XCH_END - WS_XCH) / 16);
      for (int i = F.bx * NTHR + F.tid; i < NZ; i += F.G * NTHR) xz[i] = (u32x4){0u, 0u, 0u, 0u}; }
    if (F.bx < 192) {
        const int cg = F.bx % 48, kq = F.bx / 48;
        LAS float* sc = (LAS float*)F.lds;
        LAS float* red = (LAS float*)(F.lds + 32768);
        for (int idx = F.tid; idx < 9 * 512; idx += NTHR) { const int b = idx >> 9, kk = idx & 511; const float cv = (b < 8) ? A.in[I_C][b * DM + kq * 512 + kk] : A.in[I_CCTX][kq * 512 + kk]; sc[idx] = siluf_(cv); }
        __syncthreads();
        const float* wp = A.in[I_WADA] + (size_t)(kq * 512 + F.wave * 64) * NMOD + cg * 256 + F.lane * 4;
        f32x4 acc[9];
#pragma unroll
        for (int b = 0; b < 9; ++b) acc[b] = (f32x4){0.f, 0.f, 0.f, 0.f};
#pragma unroll 8
        for (int kk = 0; kk < 64; ++kk) { const f32x4 wv = __builtin_nontemporal_load((const f32x4*)(wp + (size_t)kk * NMOD));
#pragma unroll
            for (int b = 0; b < 9; ++b) { const float s = sc[b * 512 + F.wave * 64 + kk]; acc[b] += wv * s; } }
#pragma unroll
        for (int b = 0; b < 9; ++b) *(LAS f32x4*)(red + ((F.wave * 9 + b) * 256 + F.lane * 4)) = acc[b];
        __syncthreads();
        float* modp = (float*)(F.ws + WS_MODP) + (size_t)kq * 9 * NMOD;
        for (int idx = F.tid; idx < 9 * 256; idx += NTHR) { float s = 0.f;
#pragma unroll
            for (int w = 0; w < 8; ++w) s += red[w * 9 * 256 + idx];
            modp[(size_t)(idx >> 8) * NMOD + cg * 256 + (idx & 255)] = s; }
        __syncthreads();
    } else {
        const int gid = (F.bx - 192) * NTHR + F.tid, gstride = (F.G - 192) * NTHR;
        for (int it = gid; it < 2048 + 24576 + 16384; it += gstride) {
            if (it < 2048) { const int pos = it >> 5, i = it & 31;
                const float inv = fexp2(-(float)(2 * i) * (13.287712379549449f / 64.0f));
                float rev = (float)pos * inv * 0.15915494309189535f; rev -= floorf(rev);
                f32x2 cs; cs.x = __builtin_amdgcn_cosf(rev); cs.y = __builtin_amdgcn_sinf(rev);
                ((f32x2*)(F.ws + WS_ROPE))[it] = cs;
            } else if (it < 2048 + 24576) { const int r = it - 2048, ln = r & 63, hl = (r >> 6) & 1, q = r >> 7, ntile = q % 3, ks = q / 3;
                unsigned w[4];
#pragma unroll
                for (int jj = 0; jj < 4; ++jj) { float v[2];
#pragma unroll
                    for (int e = 0; e < 2; ++e) { const int k = ks * 32 + 8 * (ln >> 4) + 2 * jj + e, n = ln & 15; float wv;
                        if (ntile < 2) wv = A.in[I_WRE][(size_t)k * 32 + ntile * 16 + n]; else wv = (n < 4) ? A.in[I_WRG][(size_t)k * 4 + n] : 0.f;
                        const float hi = bf_lo(cvt_pk_bf16(wv, 0.f)); v[e] = hl ? (wv - hi) : wv; }
                    w[jj] = cvt_pk_bf16(v[0], v[1]); }
                ((u32x4*)(F.ws + WS_WRF))[r] = (u32x4){w[0], w[1], w[2], w[3]};
            } else { const int r = it - 2048 - 24576; const f32x4 a = ((const f32x4*)A.in[I_WS])[2 * r], b = ((const f32x4*)A.in[I_WS])[2 * r + 1];
                ((u32x4*)(F.ws + WS_WSB))[r] = (u32x4){cvt_pk_bf16(a.x, a.y), cvt_pk_bf16(a.z, a.w), cvt_pk_bf16(b.x, b.y), cvt_pk_bf16(b.z, b.w)}; }
        }
    }
    __syncthreads();
    convert_strips<0>(F, A, F.ctl + CW_STRIP + 64 * rep);
}

__device__ __forceinline__ f32x4 mod4(const Ctx& F, const Args& A, int bb, int j, int col) {
    const float* mp = (const float*)(F.ws + WS_MODP) + (size_t)bb * NMOD + j * DM + col;
    const f32x4 t0 = *(const f32x4*)(A.in[I_BADA] + j * DM + col), t1 = *(const f32x4*)(mp), t2 = *(const f32x4*)(mp + (size_t)9 * NMOD), t3 = *(const f32x4*)(mp + (size_t)18 * NMOD), t4 = *(const f32x4*)(mp + (size_t)27 * NMOD);
    return ((t0 + t1) + (t2 + t3)) + t4;
}
__device__ __forceinline__ void p1_mod_vectors(const Ctx& F, const Args& A, int bb, f32x4 (&a1)[8], f32x4 (&b1)[8]) {
    const float* mp = (const float*)(F.ws + WS_MODP) + (size_t)bb * NMOD + F.lane * 4;
#pragma unroll
    for (int h = 0; h < 4; ++h) {
        f32x4 ts[2][5], th[2][5], gp[2];
#pragma unroll
        for (int jj = 0; jj < 2; ++jj) { const int co = 256 * (h * 2 + jj);
            gp[jj] = *(const f32x4*)(A.in[I_GPRE1] + F.lane * 4 + co);
            th[jj][0] = *(const f32x4*)(A.in[I_BADA] + F.lane * 4 + co); ts[jj][0] = *(const f32x4*)(A.in[I_BADA] + DM + F.lane * 4 + co);
#pragma unroll
            for (int q = 0; q < 4; ++q) { th[jj][q + 1] = *(const f32x4*)(mp + (size_t)q * 9 * NMOD + co); ts[jj][q + 1] = *(const f32x4*)(mp + (size_t)q * 9 * NMOD + DM + co); } }
#pragma unroll
        for (int jj = 0; jj < 2; ++jj) { const int j = h * 2 + jj;
            b1[j] = ((th[jj][0] + th[jj][1]) + (th[jj][2] + th[jj][3])) + th[jj][4];
            a1[j] = gp[jj] * ((((ts[jj][0] + ts[jj][1]) + (ts[jj][2] + ts[jj][3])) + ts[jj][4]) + 1.0f); }
    }
}

__device__ __forceinline__ void modf_finalize(const Ctx& F, const Args& A) {
    { const int gid = F.bx * NTHR + F.tid;
      if (gid < 8 * 4 * 512) { const int col = (gid & 511) * 4, v = (gid >> 9) & 3, b = gid >> 11; f32x4 o;
          if (v == 0) o = mod4(F, A, b, 2, col) * *(const f32x4*)(A.in[I_GPOST1] + col);
          else if (v == 1) o = *(const f32x4*)(A.in[I_GPRE2] + col) * (mod4(F, A, b, 4, col) + 1.0f);
          else if (v == 2) o = mod4(F, A, b, 3, col);
          else o = mod4(F, A, b, 5, col) * *(const f32x4*)(A.in[I_GPOST2] + col);
          *(f32x4*)((float*)(F.ws + WS_MODF) + (size_t)(b * 4 + v) * DM + col) = o; } }
}

__device__ __forceinline__ void p1_rows(const Ctx& F, const Args& A) {
    const int gw = F.vcu * NWAVES + F.wave, NGW = F.G * NWAVES, RPW = (NROW + NGW - 1) / NGW;
    const int wrow0 = F.vcu * NWAVES * RPW, wrowl = (wrow0 + NWAVES * RPW - 1 < NROW) ? wrow0 + NWAVES * RPW - 1 : NROW - 1;
    const int bb0 = wrow0 < NTOK ? (wrow0 >> 11) : 8, bb1 = wrowl < NTOK ? (wrowl >> 11) : 8;
    const int scol = F.tid * 4;
    f32x4 sgp = *(const f32x4*)(A.in[I_GPRE1] + scol), sh0 = *(const f32x4*)(A.in[I_BADA] + scol), ss0 = *(const f32x4*)(A.in[I_BADA] + DM + scol);
    f32x4 shq[2][4], ssq[2][4];
#pragma unroll
    for (int z = 0; z < 2; ++z) { const float* smp = (const float*)(F.ws + WS_MODP) + (size_t)(z ? bb1 : bb0) * NMOD + scol;
#pragma unroll
        for (int q = 0; q < 4; ++q) { shq[z][q] = *(const f32x4*)(smp + (size_t)q * 9 * NMOD); ssq[z][q] = *(const f32x4*)(smp + (size_t)q * 9 * NMOD + DM); } }
    signed char* HX = (signed char*)(F.ws + WS_HX);
    const int rbeg = gw * RPW, rend = ((gw + 1) * RPW < NROW) ? (gw + 1) * RPW : NROW;
    f32x4 v[8], v1[8], v2[8], v3[8];
#define P1_LOAD(r_, dst) do { const int rq_ = (r_); const float* src_ = rq_ < NTOK ? A.in[I_X] + (size_t)rq_ * DM : A.in[I_CTX] + (size_t)(rq_ - NTOK) * DM; \
        _Pragma("unroll") for (int j = 0; j < 8; ++j) dst[j] = __builtin_nontemporal_load((const f32x4*)(src_ + F.lane * 4 + 256 * j)); } while (0)
    if (rbeg < rend) P1_LOAD(rbeg, v);
    if (rbeg + 1 < rend) P1_LOAD(rbeg + 1, v1);
    if (rbeg + 2 < rend) P1_LOAD(rbeg + 2, v2);
#pragma unroll
    for (int z = 0; z < 2; ++z) {
        *(LAS f32x4*)(F.lds + z * 32768 + 16384 + scol * 4) = ((sh0 + shq[z][0]) + (shq[z][1] + shq[z][2])) + shq[z][3];
        *(LAS f32x4*)(F.lds + z * 32768 + scol * 4) = sgp * ((((ss0 + ssq[z][0]) + (ssq[z][1] + ssq[z][2])) + ssq[z][3]) + 1.0f); }
    __syncthreads();
    for (int row = rbeg; row < rend; ++row) {
        if (row + 3 < rend) P1_LOAD(row + 3, v3);
        const int bb = row < NTOK ? (row >> 11) : 8;
        const LAS unsigned char* mv = F.lds + (bb == bb0 ? 0 : 32768) + F.lane * 16;
        float s = 0.f;
#pragma unroll
        for (int j = 0; j < 8; ++j) s += (v[j].x * v[j].x + v[j].y * v[j].y) + (v[j].z * v[j].z + v[j].w * v[j].w);
        s = wave_sum(s);
        const float rstd = 1.0f / sqrtf(s * (1.0f / DM) + EPS);
        if (row < NTOK && F.lane == 0) ((float*)(F.ws + WS_XSQ))[row] = s;
        float mx = 0.f;
#pragma unroll
        for (int j = 0; j < 8; ++j) { v[j] = v[j] * rstd * *(const LAS f32x4*)(mv + 1024 * j) + *(const LAS f32x4*)(mv + 16384 + 1024 * j); mx = fmaxf(fmaxf(mx, fmaxf(fabsf(v[j].x), fabsf(v[j].y))), fmaxf(fabsf(v[j].z), fabsf(v[j].w))); }
        mx = wave_max(mx);
        mx = fmaxf(mx, 1e-20f); const float inv = 127.0f / mx;
        if (F.lane == 0) ((float*)(F.ws + WS_SA))[row] = mx * (1.0f / 127.0f);
#pragma unroll
        for (int j = 0; j < 8; ++j) *(unsigned*)(HX + (size_t)row * DM + F.lane * 4 + 256 * j) = q8x4m(v[j], inv);
#pragma unroll
        for (int j = 0; j < 8; ++j) { v[j] = v1[j]; v1[j] = v2[j]; v2[j] = v3[j]; }
    }
#undef P1_LOAD
}

struct SchedInProj {
    const char* A; const char* B; int G, c;
    __device__ __forceinline__ bool next(int i, pg8::Unit& u) const {
        const int L = i * G + c; if (L >= 1936) return false;
        int pm, pn; if (L < 1920) pg8::static_map(L, 64, 30, pm, pn); else { const int k = L - 1920; pm = 64 + (k >> 1); pn = k & 1; }
        u.pm = pm; u.pn = pn; u.e = 0; u.slot = 0; u.a = A + (size_t)pm * (256 * 2048); u.b = B + (size_t)pn * (256 * 2048); return true;
    }
};
struct EpiInProj {
    static constexpr bool PERM = true, PRE = true;
    unsigned char* ws; const float* qnw; const float* knw;
    __device__ __forceinline__ void pre_addr(const pg8::Unit& u, int t, const float*& pa, const float*& pb) const { pa = (const float*)(ws + WS_SA) + u.pm * 256 + t; pb = (const float*)(ws + WS_SBIN) + u.pn * 256 + t; }
    __device__ __forceinline__ void qk_tile(const i32x4 (&acc)[2][2][4][2], const pg8::Unit& u, int wr, int wc, int fr, int fq, LAS unsigned char* lds) const {
        const bool isk = (u.pn == 0);
        LAS float* P = (LAS float*)(lds + LDS_TAB);
        const LAS float* sbp = (const LAS float*)(lds + PRE_OFF) + 256 + wc * 32 + 8 * fq; const LAS float* sap = (const LAS float*)(lds + PRE_OFF);
        f32x4 sb[2][2];
#pragma unroll
        for (int bj = 0; bj < 2; ++bj) { sb[bj][0] = *(const LAS f32x4*)(sbp + bj * 128); sb[bj][1] = *(const LAS f32x4*)(sbp + bj * 128 + 4); }
        float sa8[2][4];
#pragma unroll
        for (int ai = 0; ai < 2; ++ai)
#pragma unroll
            for (int m = 0; m < 4; ++m) sa8[ai][m] = sap[ai * 128 + wr * 64 + m * 16 + fr];
#pragma unroll
        for (int ai = 0; ai < 2; ++ai)
#pragma unroll
            for (int m = 0; m < 4; ++m) { const int r = ai * 128 + wr * 64 + m * 16 + fr; const float sa = sa8[ai][m];
#pragma unroll
                for (int bj = 0; bj < 2; ++bj) { float ss = 0.f;
#pragma unroll
                    for (int n = 0; n < 2; ++n)
#pragma unroll
                        for (int j = 0; j < 4; ++j) { const float v = (float)acc[ai][bj][m][n][j] * sa * sb[bj][n][j]; ss += v * v; }
                    ss = psum32(psum16(ss));
                    if (fq == 0) P[(r * 2 + bj) * 4 + wc] = ss; } }
        asm volatile("s_waitcnt lgkmcnt(0)" ::: "memory"); __builtin_amdgcn_s_barrier(); asm volatile("" ::: "memory");
        const int hc0 = (wc >> 1) * 64 + (wc & 1) * 16 + fq * 4;
        const float* nw = isk ? knw : qnw; const f32x4 w0 = *(const f32x4*)(nw + hc0), w1 = *(const f32x4*)(nw + hc0 + 32);
        const f32x2* rope = (const f32x2*)(ws + WS_ROPE);
#pragma unroll
        for (int ai = 0; ai < 2; ++ai)
#pragma unroll
            for (int m = 0; m < 4; ++m) { const int r = ai * 128 + wr * 64 + m * 16 + fr, grow = u.pm * 256 + r; const float sa = sa8[ai][m];
                const bool isx = grow < NTOK; const int t = grow & 2047, pos = (wc >> 1) ? (t & 63) : (t >> 6);
                f32x2 cs[4];
#pragma unroll
                for (int j = 0; j < 4; ++j) cs[j] = isx ? rope[pos * 32 + (wc & 1) * 16 + fq * 4 + j] : (f32x2){1.f, 0.f};
                const int krow = isx ? ((grow >> 11) * LK + CTXL + t) : (((grow - NTOK) >> 8) * LK + ((grow - NTOK) & 255));
#pragma unroll
                for (int bj = 0; bj < 2; ++bj) { const f32x4 p4 = *(const LAS f32x4*)(P + (r * 2 + bj) * 4);
                    const float rstd = 1.0f / sqrtf(((p4.x + p4.y) + (p4.z + p4.w)) * (1.0f / HD) + EPS);
                    float o1[4], o2[4];
#pragma unroll
                    for (int j = 0; j < 4; ++j) { const float x1 = (float)acc[ai][bj][m][0][j] * sa * sb[bj][0][j] * rstd * w0[j], x2 = (float)acc[ai][bj][m][1][j] * sa * sb[bj][1][j] * rstd * w1[j];
                        o1[j] = x1 * cs[j].x - x2 * cs[j].y; o2[j] = x2 * cs[j].x + x1 * cs[j].y; }
                    bf16_t* dst = isk ? ((bf16_t*)(ws + WS_KN) + (size_t)krow * KVW + bj * HD + hc0) : ((bf16_t*)(ws + WS_Q) + (size_t)grow * QW + ((u.pn - 2) * 2 + bj) * HD + hc0);
                    *(u32x2*)dst = (u32x2){cvt_pk_bf16(o1[0], o1[1]), cvt_pk_bf16(o1[2], o1[3])};
                    *(u32x2*)(dst + 32) = (u32x2){cvt_pk_bf16(o2[0], o2[1]), cvt_pk_bf16(o2[2], o2[3])}; } }
    }
    __device__ __forceinline__ void operator()(const i32x4 (&acc)[2][2][4][2], const pg8::Unit& u, int wr, int wc, int fr, int fq, LAS unsigned char* lds) const {
        const int pn = u.pn; bf16_t* base; int ld, co, act;
        if (pn == 0 || (pn >= 2 && pn < 6)) { qk_tile(acc, u, wr, wc, fr, fq, lds); return; }
        if (pn == 0) { base = (bf16_t*)(ws + WS_KRAW); ld = 256; co = 0; act = 0; }
        else if (pn == 1) { base = (bf16_t*)(ws + WS_V); ld = 256; co = 0; act = 0; }
        else if (pn < 6) { base = (bf16_t*)(ws + WS_Q); ld = 1024; co = (pn - 2) * 256; act = 0; }
        else if (pn < 10) { base = (bf16_t*)(ws + WS_U); ld = 1024; co = (pn - 6) * 256; act = 1; }
        else if (pn < 14) { base = (bf16_t*)(ws + WS_VG); ld = 1024; co = (pn - 10) * 256; act = 1; }
        else if (pn < 22) { base = (bf16_t*)(ws + WS_GA); ld = 2048; co = (pn - 14) * 256; act = 2; }
        else { base = (bf16_t*)(ws + WS_GG); ld = 2048; co = (pn - 22) * 256; act = 2; }
        const int cw = co + wc * 32 + 8 * fq;
        const LAS float* sbp = (const LAS float*)(lds + PRE_OFF) + 256 + wc * 32 + 8 * fq; const LAS float* sap = (const LAS float*)(lds + PRE_OFF);
        f32x4 sb[2][2];
#pragma unroll
        for (int bj = 0; bj < 2; ++bj) { sb[bj][0] = *(const LAS f32x4*)(sbp + bj * 128); sb[bj][1] = *(const LAS f32x4*)(sbp + bj * 128 + 4); }
        float sa8[2][4];
#pragma unroll
        for (int ai = 0; ai < 2; ++ai)
#pragma unroll
            for (int m = 0; m < 4; ++m) sa8[ai][m] = sap[ai * 128 + wr * 64 + m * 16 + fr];
#pragma unroll
        for (int ai = 0; ai < 2; ++ai)
#pragma unroll
            for (int m = 0; m < 4; ++m) {
                const int row0 = u.pm * 256 + ai * 128 + wr * 64 + m * 16 + fr; int row = row0; const float sa = sa8[ai][m];
                if (pn == 1) row = (row < NTOK) ? ((row >> 11) * LK + CTXL + (row & 2047)) : (((row - NTOK) >> 8) * LK + ((row - NTOK) & 255));
                bf16_t* rowp = base + (size_t)row * ld + cw;
#pragma unroll
                for (int bj = 0; bj < 2; ++bj) { f32x4 v0, v1;
#pragma unroll
                    for (int j = 0; j < 4; ++j) { v0[j] = (float)acc[ai][bj][m][0][j] * sa * sb[bj][0][j]; v1[j] = (float)acc[ai][bj][m][1][j] * sa * sb[bj][1][j]; }
                    if (act == 2) {
#pragma unroll
                        for (int j = 0; j < 4; ++j) { v0[j] = sigmoidf_(v0[j]); v1[j] = sigmoidf_(v1[j]); }
                        __builtin_nontemporal_store((u32x2){q8x4m(v0, 255.0f), q8x4m(v1, 255.0f)}, (u32x2*)((unsigned char*)base + (size_t)row * ld + cw + bj * 128)); continue; }
                    if (act == 1) {
#pragma unroll
                        for (int j = 0; j < 4; ++j) { v0[j] = gelu_tanh(v0[j]); v1[j] = gelu_tanh(v1[j]); } }
                    u32x4 w; w.x = cvt_pk_bf16(v0[0], v0[1]); w.y = cvt_pk_bf16(v0[2], v0[3]); w.z = cvt_pk_bf16(v1[0], v1[1]); w.w = cvt_pk_bf16(v1[2], v1[3]);
                    if (act == 1) __builtin_nontemporal_store(w, (u32x4*)(rowp + bj * 128)); else *(u32x4*)(rowp + bj * 128) = w; } }
    }
};

namespace att {
constexpr int D = 128, NW = 8, QBLK = 32, KVBLK = 64;
constexpr float SCALE = 0.088388347648318440f, THR = 8.f;
constexpr int LDQ = QW, LDK = KVW, LDO = QW;
constexpr size_t SHM_V = KVBLK * D * 2, SHM_K = KVBLK * D * 2, SHM_ATTN = 2 * SHM_V + 2 * SHM_K + NW * 64 * 4;
#define KSWZ(row, colB) ((row) * 256 + ((colB) ^ (((row) & 7) << 4)))
#define SBAR() __builtin_amdgcn_sched_barrier(0)
__device__ __forceinline__ int crow(int r, int hi) { return (r & 3) + 8 * (r >> 2) + 4 * hi; }
__device__ __forceinline__ void partialSM(f32x16& p0, f32x16& p1, float& m_reg, float& mn, float& alpha) {
  constexpr float C = SCALE * 1.4426950408889634f;
  float pmax = p0[0]; for (int r = 1; r < 16; ++r) pmax = fmaxf(pmax, p0[r]); for (int r = 0; r < 16; ++r) pmax = fmaxf(pmax, p1[r]);
  { auto rr = __builtin_amdgcn_permlane32_swap(__float_as_uint(pmax), __float_as_uint(pmax), false, false);
    pmax = fmaxf(__uint_as_float(rr[0]), __uint_as_float(rr[1])); }
  if (__builtin_expect(__all(pmax - m_reg <= THR / SCALE), 1)) { mn = m_reg; alpha = 1.f; }
  else { mn = fmaxf(m_reg, pmax); alpha = __builtin_amdgcn_exp2f((m_reg - mn) * C); m_reg = mn; }
  float mnC = -mn * C;
  for (int r = 0; r < 16; ++r) p0[r] = fmaf(p0[r], C, mnC); for (int r = 0; r < 16; ++r) p1[r] = fmaf(p1[r], C, mnC);
  for (int r = 0; r < 16; ++r) p0[r] = __builtin_amdgcn_exp2f(p0[r]);
}
__device__ __forceinline__ void finishSM(f32x16& p0, f32x16& p1, float alpha, float& l_reg, bf16x8& pa0, bf16x8& pa1, bf16x8& pa2, bf16x8& pa3) {
  for (int r = 0; r < 16; ++r) p1[r] = __builtin_amdgcn_exp2f(p1[r]);
  float ps = 0; for (int r = 0; r < 16; ++r) ps += p0[r]; for (int r = 0; r < 16; ++r) ps += p1[r];
  { auto rr = __builtin_amdgcn_permlane32_swap(__float_as_uint(ps), __float_as_uint(ps), false, false);
    ps = __uint_as_float(rr[0]) + __uint_as_float(rr[1]); }
  l_reg = l_reg * alpha + ps;
#define PK4(P, BASE, OUT) do { unsigned a0 = cvt_pk_bf16(P[BASE + 0], P[BASE + 1]), a1 = cvt_pk_bf16(P[BASE + 2], P[BASE + 3]);   \
    unsigned b0 = cvt_pk_bf16(P[BASE + 4], P[BASE + 5]), b1 = cvt_pk_bf16(P[BASE + 6], P[BASE + 7]);                              \
    auto r0 = __builtin_amdgcn_permlane32_swap(a0, b0, false, false); auto r1 = __builtin_amdgcn_permlane32_swap(a1, b1, false, false); \
    u32x4 w = {r0[0], r1[0], r0[1], r1[1]}; OUT = *reinterpret_cast<bf16x8*>(&w); } while (0)
  PK4(p0, 0, pa0); PK4(p0, 8, pa1); PK4(p1, 0, pa2); PK4(p1, 8, pa3);
#undef PK4
}
__device__ __forceinline__ void qkt(f32x16& p0, f32x16& p1, const bf16_t* Ks, const bf16x8* qr, int r32, int hi) {
  p0 = f32x16{}; p1 = f32x16{};
  for (int d0 = 0; d0 < 8; ++d0) { int cb = (d0 * 16 + hi * 8) * 2;
    bf16x8 b0 = *reinterpret_cast<const bf16x8*>((const char*)Ks + KSWZ(r32, cb));
    bf16x8 b1 = *reinterpret_cast<const bf16x8*>((const char*)Ks + KSWZ(32 + r32, cb));
    p0 = __builtin_amdgcn_mfma_f32_32x32x16_bf16(b0, qr[d0], p0, 0, 0, 0);
    p1 = __builtin_amdgcn_mfma_f32_32x32x16_bf16(b1, qr[d0], p1, 0, 0, 0); }
}
__device__ __forceinline__ int v_st(int k, int c) { const int kk = (k & ~0xC) | ((k & 4) << 1) | ((k & 8) >> 1); return ((kk >> 3) * 4 + (c >> 5)) * 512 + ((kk & 7) * 32 + (c & 31)) * 2; }
__device__ __forceinline__ int v_rd_base(int lane) { return ((lane & 3) << 3) | (((lane >> 2) & 3) << 6) | (((lane >> 4) & 1) << 5) | (((lane >> 5) & 1) << 8); }
constexpr int v_rd_off(int d0, int ks, int half) { return d0 * 512 + ks * 4096 + half * 2048; }
template <int OFF> __device__ __forceinline__ s16x4 tr_read(int vb) {
  s16x4 r; asm volatile("ds_read_b64_tr_b16 %0, %1 offset:%2" : "=&v"(r) : "v"(vb), "i"(OFF) : "memory"); return r;
}
template <int D0> __device__ __forceinline__ void pv_one(f32x16& od, int vb, bf16x8 pa0, bf16x8 pa1, bf16x8 pa2, bf16x8 pa3) {
  const s16x4 l0 = tr_read<v_rd_off(D0, 0, 0)>(vb), h0 = tr_read<v_rd_off(D0, 0, 1)>(vb), l1 = tr_read<v_rd_off(D0, 1, 0)>(vb), h1 = tr_read<v_rd_off(D0, 1, 1)>(vb);
  const s16x4 l2 = tr_read<v_rd_off(D0, 2, 0)>(vb), h2 = tr_read<v_rd_off(D0, 2, 1)>(vb), l3 = tr_read<v_rd_off(D0, 3, 0)>(vb), h3 = tr_read<v_rd_off(D0, 3, 1)>(vb);
  asm volatile("s_waitcnt lgkmcnt(0)" ::: "memory"); SBAR();
#define PK(L, H) (bf16x8){L[0], L[1], L[2], L[3], H[0], H[1], H[2], H[3]}
  od = __builtin_amdgcn_mfma_f32_32x32x16_bf16(pa0, PK(l0, h0), od, 0, 0, 0);
  od = __builtin_amdgcn_mfma_f32_32x32x16_bf16(pa1, PK(l1, h1), od, 0, 0, 0);
  od = __builtin_amdgcn_mfma_f32_32x32x16_bf16(pa2, PK(l2, h2), od, 0, 0, 0);
  od = __builtin_amdgcn_mfma_f32_32x32x16_bf16(pa3, PK(l3, h3), od, 0, 0, 0);
#undef PK
}
template <int D0> __device__ __forceinline__ void pv_reads(int vb, s16x4 (&v)[8]) {
  v[0] = tr_read<v_rd_off(D0, 0, 0)>(vb); v[1] = tr_read<v_rd_off(D0, 0, 1)>(vb); v[2] = tr_read<v_rd_off(D0, 1, 0)>(vb); v[3] = tr_read<v_rd_off(D0, 1, 1)>(vb);
  v[4] = tr_read<v_rd_off(D0, 2, 0)>(vb); v[5] = tr_read<v_rd_off(D0, 2, 1)>(vb); v[6] = tr_read<v_rd_off(D0, 3, 0)>(vb); v[7] = tr_read<v_rd_off(D0, 3, 1)>(vb);
}
__device__ __forceinline__ void pv_mma(f32x16& od, const s16x4 (&v)[8], bf16x8 pa0, bf16x8 pa1, bf16x8 pa2, bf16x8 pa3) {
  asm volatile("s_waitcnt lgkmcnt(0)" ::: "memory"); SBAR();
#define PK(L, H) (bf16x8){L[0], L[1], L[2], L[3], H[0], H[1], H[2], H[3]}
  od = __builtin_amdgcn_mfma_f32_32x32x16_bf16(pa0, PK(v[0], v[1]), od, 0, 0, 0);
  od = __builtin_amdgcn_mfma_f32_32x32x16_bf16(pa1, PK(v[2], v[3]), od, 0, 0, 0);
  od = __builtin_amdgcn_mfma_f32_32x32x16_bf16(pa2, PK(v[4], v[5]), od, 0, 0, 0);
  od = __builtin_amdgcn_mfma_f32_32x32x16_bf16(pa3, PK(v[6], v[7]), od, 0, 0, 0);
#undef PK
}
__device__ __forceinline__ void pv_sm(f32x16* o, int vb, bf16x8 pa0, bf16x8 pa1, bf16x8 pa2, bf16x8 pa3, f32x16& p0, f32x16& p1, float& m_reg, float& mn, float& alpha) {
  constexpr float C = SCALE * 1.4426950408889634f;
  s16x4 v[8]; float mnC;
  pv_reads<0>(vb, v); SBAR();
  { float pmax = p0[0]; for (int r = 1; r < 16; ++r) pmax = fmaxf(pmax, p0[r]); for (int r = 0; r < 16; ++r) pmax = fmaxf(pmax, p1[r]);
    { auto rr = __builtin_amdgcn_permlane32_swap(__float_as_uint(pmax), __float_as_uint(pmax), false, false);
      pmax = fmaxf(__uint_as_float(rr[0]), __uint_as_float(rr[1])); }
    if (__builtin_expect(__all(pmax - m_reg <= THR / SCALE), 1)) { mn = m_reg; alpha = 1.f; }
    else { mn = fmaxf(m_reg, pmax); alpha = __builtin_amdgcn_exp2f((m_reg - mn) * C); m_reg = mn; }
    mnC = -mn * C; }
  pv_mma(o[0], v, pa0, pa1, pa2, pa3);
  pv_reads<1>(vb, v); SBAR();
  for (int r = 0; r < 16; ++r) p0[r] = fmaf(p0[r], C, mnC);
  pv_mma(o[1], v, pa0, pa1, pa2, pa3);
  pv_reads<2>(vb, v); SBAR();
  for (int r = 0; r < 16; ++r) p1[r] = fmaf(p1[r], C, mnC);
  pv_mma(o[2], v, pa0, pa1, pa2, pa3);
  pv_reads<3>(vb, v); SBAR();
  for (int r = 0; r < 16; ++r) p0[r] = __builtin_amdgcn_exp2f(p0[r]);
  pv_mma(o[3], v, pa0, pa1, pa2, pa3);
}
__device__ __forceinline__ void pv_d0(f32x16* o, int vb, bf16x8 pa0, bf16x8 pa1, bf16x8 pa2, bf16x8 pa3) {
  pv_one<0>(o[0], vb, pa0, pa1, pa2, pa3); pv_one<1>(o[1], vb, pa0, pa1, pa2, pa3); pv_one<2>(o[2], vb, pa0, pa1, pa2, pa3); pv_one<3>(o[3], vb, pa0, pa1, pa2, pa3);
}
__device__ __forceinline__ void attn_dense_body(const bf16_t* __restrict__ Qb, const bf16_t* __restrict__ Kh, const bf16_t* __restrict__ Vh, bf16_t* __restrict__ Ob, int seq, char* lds) {
  const int tid = threadIdx.x, wid = tid >> 6, lane = tid & 63, r32 = lane & 31, hi = lane >> 5;
  bf16_t* V_lds = (bf16_t*)lds; bf16_t* K_lds = (bf16_t*)(lds + 2 * SHM_V);
  float* ws = (float*)(lds + 2 * SHM_V + 2 * SHM_K) + wid * 64; float* li_l = ws; float* al_l = ws + 32;
  float m_reg = -1e30f, l_reg = 0; f32x16 o[4] = {}; bf16x8 qr[8];
  const bf16_t* Qw = Qb + (long)(wid * QBLK + r32) * LDQ + hi * 8;
#pragma unroll
  for (int d0 = 0; d0 < 8; ++d0) qr[d0] = *reinterpret_cast<const bf16x8*>(Qw + d0 * 16);
  const int sr = tid >> 4, sc = (tid & 15) * 8, vst0 = v_st(sr, sc), vst1 = v_st(32 + sr, sc);
  const int vb0 = (int)(uintptr_t)V_lds + v_rd_base(lane);
  struct { bf16x8 vs0, vs1, ks0, ks1; } sr_[2];
#define SLOAD(i, k0) do { sr_[i].vs0 = *(const bf16x8*)(&Vh[(long)((k0) + sr) * LDK + sc]); sr_[i].vs1 = *(const bf16x8*)(&Vh[(long)((k0) + 32 + sr) * LDK + sc]); \
    sr_[i].ks0 = *(const bf16x8*)(&Kh[(long)((k0) + sr) * LDK + sc]); sr_[i].ks1 = *(const bf16x8*)(&Kh[(long)((k0) + 32 + sr) * LDK + sc]); } while (0)
#define SWRITE(b, i) do { *(bf16x8*)((char*)V_lds + (b) * SHM_V + vst0) = sr_[i].vs0;          \
    *(bf16x8*)((char*)V_lds + (b) * SHM_V + vst1) = sr_[i].vs1; int kc = sc * 2;               \
    *(bf16x8*)((char*)K_lds + (b) * SHM_K + KSWZ(sr, kc)) = sr_[i].ks0;                       \
    *(bf16x8*)((char*)K_lds + (b) * SHM_K + KSWZ(32 + sr, kc)) = sr_[i].ks1; } while (0)
#define SWAIT() asm volatile("s_waitcnt vmcnt(4)" ::: "memory")
#define RESC(a) do { if (__any((a) < 1.f)) { if (hi == 0) al_l[r32] = (a); asm volatile("s_waitcnt lgkmcnt(0)" ::: "memory"); \
    for (int d = 0; d < 4; ++d) for (int r = 0; r < 16; ++r) o[d][r] *= al_l[crow(r, hi)]; } } while (0)
  f32x16 pA0, pA1, pB0, pB1; float mnA, mnB, alA, alB; bf16x8 pa0, pa1, pa2, pa3; const int NT = seq / KVBLK;
  constexpr int SE = 0, SO = 1;
  SLOAD(SE, 0); asm volatile("s_waitcnt vmcnt(0)" ::: "memory"); SWRITE(0, SE); __syncthreads();
  qkt(pA0, pA1, K_lds, qr, r32, hi); partialSM(pA0, pA1, m_reg, mnA, alA);
  SLOAD(SO, KVBLK); if (2 < NT) SLOAD(SE, 2 * KVBLK);
  SWAIT(); SWRITE(1, SO); __syncthreads();
  for (int j = 1; j + 1 < NT; j += 2) {
    SBAR(); qkt(pB0, pB1, (bf16_t*)((char*)K_lds + SHM_K), qr, r32, hi);
    finishSM(pA0, pA1, alA, l_reg, pa0, pa1, pa2, pa3); SBAR();
    SLOAD(SO, (j + 2) * KVBLK); SBAR();
    pv_sm(o, vb0, pa0, pa1, pa2, pa3, pB0, pB1, m_reg, mnB, alB);
    __syncthreads(); SWAIT(); SWRITE(0, SE);
    RESC(alB); __syncthreads();
    SBAR(); qkt(pA0, pA1, K_lds, qr, r32, hi);
    finishSM(pB0, pB1, alB, l_reg, pa0, pa1, pa2, pa3); SBAR();
    if (j + 3 < NT) SLOAD(SE, (j + 3) * KVBLK); SBAR();
    pv_sm(o, vb0 + (int)SHM_V, pa0, pa1, pa2, pa3, pA0, pA1, m_reg, mnA, alA);
    __syncthreads(); SWAIT(); SWRITE(1, SO);
    RESC(alA); __syncthreads();
  }
  SBAR(); qkt(pB0, pB1, (bf16_t*)((char*)K_lds + SHM_K), qr, r32, hi);
  finishSM(pA0, pA1, alA, l_reg, pa0, pa1, pa2, pa3); SBAR();
  pv_sm(o, vb0, pa0, pa1, pa2, pa3, pB0, pB1, m_reg, mnB, alB);
  __syncthreads(); RESC(alB);
  finishSM(pB0, pB1, alB, l_reg, pa0, pa1, pa2, pa3); SBAR();
  pv_d0(o, vb0 + (int)SHM_V, pa0, pa1, pa2, pa3);
  if (hi == 0) li_l[r32] = l_reg; asm volatile("s_waitcnt lgkmcnt(0)" ::: "memory");
  float rli[16];
#pragma unroll
  for (int r = 0; r < 16; ++r) rli[r] = __builtin_amdgcn_rcpf(li_l[crow(r, hi)]);
  __syncthreads();
  int tz = threadIdx.x; asm volatile("" : "+v"(tz));
  const int lane_e = tz & 63, wid_e = tz >> 6, r32e = lane_e & 31, hie = lane_e >> 5;
  bf16_t* Ow = Ob + (long)(wid_e * QBLK) * LDO;
  char* ost = lds + wid_e * 8704;
#pragma unroll
  for (int r = 0; r < 16; ++r) { int orow = crow(r, hie);
#pragma unroll
    for (int d0 = 0; d0 < 4; ++d0) *(bf16_t*)(ost + orow * 272 + (d0 * 32 + r32e) * 2) = (bf16_t)(cvt_pk_bf16(o[d0][r] * rli[r], 0.f) & 0xffffu); }
  asm volatile("s_waitcnt lgkmcnt(0)" ::: "memory");
#pragma unroll
  for (int i = 0; i < 8; ++i) { const int row = i * 4 + (lane_e >> 4), ch = lane_e & 15;
    const u32x4 v = *(const u32x4*)(ost + row * 272 + ch * 16); *(u32x4*)(Ow + (long)row * LDO + ch * 8) = v; }
  __syncthreads();
#undef SLOAD
#undef SWRITE
#undef SWAIT
#undef RESC
}
}

__device__ __forceinline__ void gmlp_item(const Ctx& F, const Args& A, int item) {
    const int g = item & 7, nq = (item >> 3) & 3, b = item >> 5;
    const int c0 = g * 128;
    LAS unsigned char* T = F.lds;
    const bf16_t* VG = (const bf16_t*)(F.ws + WS_VG); const bf16_t* U = (const bf16_t*)(F.ws + WS_U); bf16_t* GM = (bf16_t*)(F.ws + WS_GM);
    const int wr = F.wave >> 2, wc = F.wave & 3, fr = F.lane & 15, fq = F.lane >> 4;
    const int q = F.tid >> 2, seg = F.tid & 3;
    u32x4 raw[4], rawn[4]; f32x4 lw[8]; bf16x8 af[4][4]; u32x2 uu[4][2], uun[4][2]; float bsv[4];
#define GM_LOAD(RAW, UU, row0_) do { const bf16_t* src_ = VG + (size_t)((row0_) + q) * GMW + c0 + seg * 32; \
        _Pragma("unroll") for (int i = 0; i < 4; ++i) RAW[i] = __builtin_nontemporal_load((const u32x4*)(src_ + i * 8)); \
        _Pragma("unroll") for (int m = 0; m < 4; ++m) { const int p_ = wr * 64 + m * 16 + fr; \
            _Pragma("unroll") for (int nn = 0; nn < 2; ++nn) UU[m][nn] = __builtin_nontemporal_load((const u32x2*)(U + (size_t)((row0_) + p_) * GMW + c0 + wc * 32 + nn * 16 + 4 * fq)); } } while (0)
    const int rowb = b * SEQ + nq * 512;
    GM_LOAD(raw, uu, rowb);
    { const float* lnw = A.in[I_GMLN] + c0 + seg * 32;
#pragma unroll
      for (int i = 0; i < 8; ++i) lw[i] = *(const f32x4*)(lnw + i * 4); }
    const bf16_t* WsB = (const bf16_t*)(F.ws + WS_WSB) + (size_t)g * 128 * 128;
#pragma unroll
    for (int kk = 0; kk < 4; ++kk)
#pragma unroll
        for (int m = 0; m < 4; ++m) af[kk][m] = *(const bf16x8*)(WsB + (size_t)(wr * 64 + m * 16 + fr) * 128 + kk * 32 + fq * 8);
#pragma unroll
    for (int m = 0; m < 4; ++m) bsv[m] = A.in[I_BS][g * 128 + wr * 64 + m * 16 + fr];
#pragma unroll 1
    for (int ch = 0; ch < 4; ++ch) { const int row0 = rowb + ch * 128;
        { float v[32];
#pragma unroll
          for (int i = 0; i < 4; ++i) { v[i * 8 + 0] = bf_lo(raw[i].x); v[i * 8 + 1] = bf_hi(raw[i].x); v[i * 8 + 2] = bf_lo(raw[i].y); v[i * 8 + 3] = bf_hi(raw[i].y); v[i * 8 + 4] = bf_lo(raw[i].z); v[i * 8 + 5] = bf_hi(raw[i].z); v[i * 8 + 6] = bf_lo(raw[i].w); v[i * 8 + 7] = bf_hi(raw[i].w); }
          if (ch < 3) {
              const bf16_t* src_ = VG + (size_t)(row0 + 128 + q) * GMW + c0 + seg * 32;
#pragma unroll
              for (int i = 0; i < 4; ++i) rawn[i] = __builtin_nontemporal_load((const u32x4*)(src_ + i * 8)); }
          float s = 0.f;
#pragma unroll
          for (int i = 0; i < 32; ++i) s += v[i];
          s += dppf<0xB1>(s); s += dppf<0x4E>(s);
          const float mean = s * (1.0f / 128.0f); float s2 = 0.f;
#pragma unroll
          for (int i = 0; i < 32; ++i) { v[i] -= mean; s2 += v[i] * v[i]; }
          s2 += dppf<0xB1>(s2); s2 += dppf<0x4E>(s2);
          const float rstd = 1.0f / sqrtf(s2 * (1.0f / 128.0f) + EPS);
#pragma unroll
          for (int i = 0; i < 32; ++i) { const float y = v[i] * rstd * lw[i >> 2][i & 3]; *(LAS bf16_t*)(T + (seg * 32 + i) * 272 + q * 2) = (bf16_t)(cvt_pk_bf16(y, 0.f) & 0xffffu); } }
        __syncthreads();
        f32x4 acc[4][2];
#pragma unroll
        for (int m = 0; m < 4; ++m) { acc[m][0] = (f32x4){0.f, 0.f, 0.f, 0.f}; acc[m][1] = (f32x4){0.f, 0.f, 0.f, 0.f}; }
#pragma unroll
        for (int kk = 0; kk < 4; ++kk) {
            bf16x8 bfr[2];
#pragma unroll
            for (int nn = 0; nn < 2; ++nn) bfr[nn] = *(const LAS bf16x8*)(T + (wc * 32 + nn * 16 + fr) * 272 + (kk * 32 + fq * 8) * 2);
#pragma unroll
            for (int m = 0; m < 4; ++m)
#pragma unroll
                for (int nn = 0; nn < 2; ++nn) acc[m][nn] = __builtin_amdgcn_mfma_f32_16x16x32_bf16(bfr[nn], af[kk][m], acc[m][nn], 0, 0, 0);
        }
#pragma unroll
        for (int m = 0; m < 4; ++m) { const int p = wr * 64 + m * 16 + fr;
#pragma unroll
            for (int nn = 0; nn < 2; ++nn) { const int c = c0 + wc * 32 + nn * 16 + 4 * fq; const size_t off = (size_t)(row0 + p) * GMW + c;
                const f32x4 sv = acc[m][nn] + bsv[m];
                *(u32x2*)(GM + off) = (u32x2){cvt_pk_bf16(bf_lo(uu[m][nn].x) * sv[0], bf_hi(uu[m][nn].x) * sv[1]), cvt_pk_bf16(bf_lo(uu[m][nn].y) * sv[2], bf_hi(uu[m][nn].y) * sv[3])};
                if (ch < 3) uu[m][nn] = __builtin_nontemporal_load((const u32x2*)(U + (size_t)(row0 + 128 + p) * GMW + c)); } }
#pragma unroll
        for (int i = 0; i < 4; ++i) raw[i] = rawn[i];
        __syncthreads();
    }
#undef GM_LOAD
}

__device__ __forceinline__ void p4_attention(const Ctx& F, const Args& A, char* lds_generic, int rep) {
    unsigned* const cb = F.ctl; (void)rep;
    modf_finalize(F, A);
    if (((F.bx >> 3) & 7) < NCONV8) { convert_strips<1>(F, A, cb + CW_STRIP2); convert_strips<2>(F, A, cb + CW_WORK2);
        convert_strips<4>(F, A, cb + CW_WORK); convert_strips<3>(F, A, cb + CW_STRIP3); __syncthreads(); }
    const bf16_t* Q = (const bf16_t*)(F.ws + WS_Q); const bf16_t* KN = (const bf16_t*)(F.ws + WS_KN); const bf16_t* V = (const bf16_t*)(F.ws + WS_V); bf16_t* O = (bf16_t*)(F.ws + WS_ATT);
    const int xl = F.bx & 7;
    for (;;) {
        LAS unsigned* bw = (LAS unsigned*)(F.lds + LDS_MISC);
        if (F.tid == 0) bw[0] = __hip_atomic_fetch_add(cb + CW_QA + 64 * xl, 1u, RLX_AGENT);
        __syncthreads();
        const int id = (int)bw[0];
        __syncthreads();
        if (id >= 64) break;
        const int grp = xl + 8 * (id >> 5), w = id & 31, b = grp >> 1, kvh = grp & 1, h = kvh * 4 + (w >> 3), qb = w & 7;
        const size_t qoff = ((size_t)(b * SEQ + qb * 256)) * QW + h * HD, koff = (size_t)b * LK * KVW + kvh * HD;
        att::attn_dense_body(Q + qoff, KN + koff, V + koff, O + qoff, LK, lds_generic);
    }
    for (;;) {
        LAS unsigned* bw = (LAS unsigned*)(F.lds + LDS_MISC);
        if (F.tid == 0) bw[0] = __hip_atomic_fetch_add(cb + CW_QB + 64 * xl, 1u, RLX_AGENT);
        __syncthreads();
        const int id = (int)bw[0];
        __syncthreads();
        if (id >= 32) break;
        gmlp_item(F, A, xl * 32 + id);
    }
}

__device__ __forceinline__ void row_max_exchange(LAS unsigned char* lds, unsigned long long* X  , unsigned* tmo, int pn, int ew, int tid, float* scale_out  ) {
    LAS float* M = (LAS float*)(lds + XCH_M); LAS float* R = (LAS float*)(lds + XCH_R);
    asm volatile("s_waitcnt lgkmcnt(0)" ::: "memory"); __builtin_amdgcn_s_barrier(); asm volatile("" ::: "memory");
    if (ew < 4) { const f32x4 m4 = *(const LAS f32x4*)(M + tid * 4); const float v = fmaxf(fmaxf(m4.x, m4.y), fmaxf(m4.z, m4.w));
        __hip_atomic_store(X + pn * 256 + tid, (1ull << 32) | (unsigned long long)__float_as_uint(v), RLX_AGENT);
        float r = 1e-20f; unsigned sp = 0;
        for (;;) { bool ok = true; r = 1e-20f;
#pragma unroll
            for (int q = 0; q < 8; ++q) { const unsigned long long g = __hip_atomic_load(X + q * 256 + tid, RLX_AGENT); ok &= (unsigned)(g >> 32) == 1u; r = fmaxf(r, __uint_as_float((unsigned)g)); }
            if (__all(ok)) break;
            __builtin_amdgcn_s_sleep(1);
            if (++sp > (1u << 20)) { if ((tid & 63) == 0) __hip_atomic_store(tmo, 0xE8u, RLX_AGENT); break; } }
        R[tid] = r; if (scale_out) scale_out[tid] = r * (1.0f / 127.0f); }
    asm volatile("s_waitcnt lgkmcnt(0)" ::: "memory"); __builtin_amdgcn_s_barrier(); asm volatile("" ::: "memory");
}

__device__ __forceinline__ void p5_quant_rows(const Ctx& F) {
    const int rl = F.tid >> 4, seg = F.tid & 15;
    for (int rb = F.bx; rb < NTOK / 64; rb += F.G) {
    u32x4 v[4][8];
#pragma unroll
    for (int sh = 0; sh < 4; ++sh) { const int row = rb * 64 + (sh & 1) * 32 + rl; const bf16_t* src = (const bf16_t*)(F.ws + ((sh >> 1) ? WS_GM : WS_ATT)) + (size_t)row * 1024 + seg * 8;
#pragma unroll
        for (int j = 0; j < 8; ++j) v[sh][j] = __builtin_nontemporal_load((const u32x4*)(src + j * 128)); }
#pragma unroll
    for (int sh = 0; sh < 4; ++sh) { const int row = rb * 64 + (sh & 1) * 32 + rl; float mx = 0.f;
#pragma unroll
        for (int j = 0; j < 8; ++j)
#pragma unroll
            for (int e = 0; e < 4; ++e) mx = fmaxf(mx, fmaxf(fabsf(bf_lo(v[sh][j][e])), fabsf(bf_hi(v[sh][j][e]))));
        mx = fmaxf(mx, dppf<0xB1>(mx)); mx = fmaxf(mx, dppf<0x4E>(mx)); mx = fmaxf(mx, dppf<0x124>(mx)); mx = fmaxf(mx, dppf<0x128>(mx));
        mx = fmaxf(mx, 1e-20f); const float inv = 127.0f / mx;
        if (seg == 0) ((float*)(F.ws + ((sh >> 1) ? WS_SAGM : WS_SAATT)))[row] = mx * (1.0f / 127.0f);
        signed char* dst = (signed char*)(F.ws + ((sh >> 1) ? WS_GM8 : WS_ATT8)) + (size_t)row * 1024 + seg * 8;
#pragma unroll
        for (int j = 0; j < 8; ++j) { const u32x4 w = v[sh][j];
            *(u32x2*)(dst + j * 128) = (u32x2){q8x4m((f32x4){bf_lo(w.x), bf_hi(w.x), bf_lo(w.y), bf_hi(w.y)}, inv), q8x4m((f32x4){bf_lo(w.z), bf_hi(w.z), bf_lo(w.w), bf_hi(w.w)}, inv)}; } }
    }
}
struct SchedF1 {
    unsigned char* ws; int G, c;
    __device__ __forceinline__ bool next(int i, pg8::Unit& u) const {
        const int ir = i >> 1, pass = i & 1; if (ir * G + c >= 512) return false;
        const int w = (c >> 3) + (G >> 3) * ir, pm = 8 * (c & 7) + (w >> 3), pn = w & 7;
        u.pm = pm; u.pn = pn; u.e = pass; u.slot = 0;
        u.a = (const char*)(ws + (pass ? WS_GM8 : WS_ATT8)) + (size_t)pm * (256 * 1024); u.b = (const char*)(ws + (pass ? WS_WBG : WS_WBA)) + (size_t)pn * (256 * 1024); return true;
    }
};
struct EpiF1 {
    static constexpr bool PERM = true, PRE = false;
    unsigned char* ws; unsigned* ctl;
    __device__ __forceinline__ void operator()(const i32x4 (&acc)[2][2][4][2], const pg8::Unit& u, int wr, int wc, int fr, int fq, LAS unsigned char* lds) const {
        const unsigned char* gate = (const unsigned char*)(ws + (u.e ? WS_GG : WS_GA)); bf16_t* mg = (bf16_t*)(ws + WS_MG);
        const size_t off0 = (size_t)(u.pm * 256 + wr * 64 + fr) * DM + u.pn * 256 + wc * 32 + 8 * fq;
        const float* sap = (const float*)(ws + (u.e ? WS_SAGM : WS_SAATT)) + u.pm * 256 + wr * 64 + fr;
        const float* sbp = (const float*)(ws + (u.e ? WS_SBBG : WS_SBBA)) + u.pn * 256 + wc * 32 + 8 * fq;
        if (!u.e) {
            f32x4 sb[2][2];
#pragma unroll
            for (int bj = 0; bj < 2; ++bj) { sb[bj][0] = *(const f32x4*)(sbp + bj * 128); sb[bj][1] = *(const f32x4*)(sbp + bj * 128 + 4); }
            u32x2 gt[2][4][2]; float sa[2][4];
#pragma unroll
            for (int ai = 0; ai < 2; ++ai)
#pragma unroll
                for (int m = 0; m < 4; ++m) { sa[ai][m] = sap[ai * 128 + m * 16];
#pragma unroll
                    for (int bj = 0; bj < 2; ++bj) gt[ai][m][bj] = __builtin_nontemporal_load((const u32x2*)(gate + off0 + (size_t)(ai * 128 + m * 16) * DM + bj * 128)); }
#pragma unroll
            for (int ai = 0; ai < 2; ++ai) {
#pragma unroll
                for (int m = 0; m < 4; ++m) { const float sk = sa[ai][m] * (1.0f / 255.0f);
#pragma unroll
                    for (int bj = 0; bj < 2; ++bj) { const size_t off = off0 + (size_t)(ai * 128 + m * 16) * DM + bj * 128;
                        const u32x2 g = gt[ai][m][bj]; f32x4 v0, v1;
#pragma unroll
                        for (int j = 0; j < 4; ++j) { v0[j] = (float)acc[ai][bj][m][0][j] * sk * sb[bj][0][j]; v1[j] = (float)acc[ai][bj][m][1][j] * sk * sb[bj][1][j]; }
                        *(u32x4*)(mg + off) = (u32x4){cvt_pk_bf16((float)(g.x & 0xffu) * v0[0], (float)((g.x >> 8) & 0xffu) * v0[1]), cvt_pk_bf16((float)((g.x >> 16) & 0xffu) * v0[2], (float)(g.x >> 24) * v0[3]),
                                                        cvt_pk_bf16((float)(g.y & 0xffu) * v1[0], (float)((g.y >> 8) & 0xffu) * v1[1]), cvt_pk_bf16((float)((g.y >> 16) & 0xffu) * v1[2], (float)(g.y >> 24) * v1[3])}; } } }
            return; }
        LAS float* M = (LAS float*)(lds + XCH_M); const LAS float* R = (const LAS float*)(lds + XCH_R);
        unsigned mvp[2][4][2][4];
        LAS float* sbl = (LAS float*)(lds + LDS_TAB);
        { int tz = threadIdx.x; asm volatile("" : "+v"(tz)); if (tz < 64) *(LAS f32x4*)(sbl + tz * 4) = *(const f32x4*)((const float*)(ws + WS_SBBG) + u.pn * 256 + tz * 4); }
        asm volatile("s_waitcnt lgkmcnt(0)" ::: "memory"); __builtin_amdgcn_s_barrier(); asm volatile("" ::: "memory");
        const LAS float* sbq = sbl + wc * 32 + 8 * fq;
        u32x2 gt[3][2]; u32x4 pr[3][2]; float sa[3];
#define F1B_LOAD(g_, buf_) do { const int rg_ = ((g_) >> 2) * 128 + ((g_) & 3) * 16; sa[buf_] = sap[rg_]; \
            _Pragma("unroll") for (int bj = 0; bj < 2; ++bj) { const size_t off_ = off0 + (size_t)rg_ * DM + bj * 128; gt[buf_][bj] = __builtin_nontemporal_load((const u32x2*)(gate + off_)); pr[buf_][bj] = __builtin_nontemporal_load((const u32x4*)(mg + off_)); } } while (0)
        F1B_LOAD(0, 0); F1B_LOAD(1, 1);
#pragma unroll
        for (int g8 = 0; g8 < 8; ++g8) { const int ai = g8 >> 2, m = g8 & 3, cb = g8 % 3;
            if (g8 + 2 < 8) { if ((g8 + 2) % 3 == 0) F1B_LOAD(g8 + 2, 0); else if ((g8 + 2) % 3 == 1) F1B_LOAD(g8 + 2, 1); else F1B_LOAD(g8 + 2, 2); }
            __builtin_amdgcn_sched_barrier(0);
            { float mx = 0.f; const float k = sa[cb] * (1.0f / 255.0f);
#pragma unroll
                for (int bj = 0; bj < 2; ++bj) { const u32x2 g = gt[cb][bj]; const u32x4 p = pr[cb][bj]; const i32x4 a0 = acc[ai][bj][m][0], a1 = acc[ai][bj][m][1]; const f32x4 s0 = *(const LAS f32x4*)(sbq + bj * 128) * k, s1 = *(const LAS f32x4*)(sbq + bj * 128 + 4) * k;
                    float r[8];
                    r[0] = fmaf((float)a0[0], (float)(g.x & 0xffu) * s0[0], bf_lo(p.x)); r[1] = fmaf((float)a0[1], (float)((g.x >> 8) & 0xffu) * s0[1], bf_hi(p.x)); r[2] = fmaf((float)a0[2], (float)((g.x >> 16) & 0xffu) * s0[2], bf_lo(p.y)); r[3] = fmaf((float)a0[3], (float)(g.x >> 24) * s0[3], bf_hi(p.y));
                    r[4] = fmaf((float)a1[0], (float)(g.y & 0xffu) * s1[0], bf_lo(p.z)); r[5] = fmaf((float)a1[1], (float)((g.y >> 8) & 0xffu) * s1[1], bf_hi(p.z)); r[6] = fmaf((float)a1[2], (float)((g.y >> 16) & 0xffu) * s1[2], bf_lo(p.w)); r[7] = fmaf((float)a1[3], (float)(g.y >> 24) * s1[3], bf_hi(p.w));
#pragma unroll
                    for (int q = 0; q < 8; ++q) mx = fmaxf(mx, fabsf(r[q]));
#pragma unroll
                    for (int q = 0; q < 4; ++q) mvp[ai][m][bj][q] = cvt_pk_bf16(r[2 * q], r[2 * q + 1]); }
                mx = pmax32(pmax16(mx));
                if (fq == 0) M[(ai * 128 + wr * 64 + m * 16 + fr) * 4 + wc] = mx; }
            asm volatile("" ::: "memory"); __builtin_amdgcn_sched_barrier(0); }
#undef F1B_LOAD
        const int ew = __builtin_amdgcn_readfirstlane(wr * 4 + wc), tid = ew * 64 + fq * 16 + fr;
        row_max_exchange(lds, (unsigned long long*)(ws + WS_XCH2) + (size_t)u.pm * 8 * 256, ctl + CW_TMO, u.pn, ew, tid, u.pn == 0 ? (float*)(ws + WS_SAMG) + u.pm * 256 : nullptr);
        signed char* mg8 = (signed char*)(ws + WS_MG8);
        int tz2 = tid; asm volatile("" : "+v"(tz2));
        const int fr2 = tz2 & 15, fq2 = (tz2 >> 4) & 3, wr2 = tz2 >> 8, wc2 = (tz2 >> 6) & 3;
        const size_t off0b = (size_t)(u.pm * 256 + wr2 * 64 + fr2) * DM + u.pn * 256 + wc2 * 32 + 8 * fq2;
#pragma unroll
        for (int ai = 0; ai < 2; ++ai)
#pragma unroll
            for (int m = 0; m < 4; ++m) { const float inv = 127.0f / R[ai * 128 + wr2 * 64 + m * 16 + fr2];
#pragma unroll
                for (int bj = 0; bj < 2; ++bj) { const unsigned* r = mvp[ai][m][bj];
                    *(u32x2*)(mg8 + off0b + (size_t)(ai * 128 + m * 16) * DM + bj * 128) = (u32x2){q8x4m((f32x4){bf_lo(r[0]), bf_hi(r[0]), bf_lo(r[1]), bf_hi(r[1])}, inv), q8x4m((f32x4){bf_lo(r[2]), bf_hi(r[2]), bf_lo(r[3]), bf_hi(r[3])}, inv)}; } }
    }
};

struct SchedF2 {
    unsigned char* ws; int G, c;
    __device__ __forceinline__ bool next(int i, pg8::Unit& u) const {
        const int L = i * G + c; if (L >= 512) return false;
        int pm, pn; pg8::static_map(L, 64, 8, pm, pn);
        u.pm = pm; u.pn = pn; u.e = 0; u.slot = 0;
        u.a = (const char*)(ws + WS_MG8) + (size_t)pm * (256 * 2048); u.b = (const char*)(ws + WS_WO) + (size_t)pn * (256 * 2048); return true;
    }
};
struct EpiF2 {
    static constexpr bool PERM = true, PRE = true;
    unsigned char* ws;
    __device__ __forceinline__ void pre_addr(const pg8::Unit& u, int t, const float*& pa, const float*& pb) const { pa = (const float*)(ws + WS_SAMG) + u.pm * 256 + t; pb = (const float*)(ws + WS_SBWO) + u.pn * 256 + t; }
    __device__ __forceinline__ void operator()(const i32x4 (&acc)[2][2][4][2], const pg8::Unit& u, int wr, int wc, int fr, int fq, LAS unsigned char* lds) const {
        bf16_t* mix = (bf16_t*)(ws + WS_MIX); const LAS float* sap = (const LAS float*)(lds + PRE_OFF);
        const LAS float* sbp = (const LAS float*)(lds + PRE_OFF) + 256 + wc * 32 + 8 * fq;
        f32x4 sb[2][2];
#pragma unroll
        for (int bj = 0; bj < 2; ++bj) { sb[bj][0] = *(const LAS f32x4*)(sbp + bj * 128); sb[bj][1] = *(const LAS f32x4*)(sbp + bj * 128 + 4); }
        float sa8[2][4];
#pragma unroll
        for (int ai = 0; ai < 2; ++ai)
#pragma unroll
            for (int m = 0; m < 4; ++m) sa8[ai][m] = sap[ai * 128 + wr * 64 + m * 16 + fr];
#pragma unroll
        for (int ai = 0; ai < 2; ++ai)
#pragma unroll
            for (int m = 0; m < 4; ++m) { const int row = u.pm * 256 + ai * 128 + wr * 64 + m * 16 + fr; const float sa = sa8[ai][m];
#pragma unroll
                for (int bj = 0; bj < 2; ++bj) { f32x4 v0, v1;
#pragma unroll
                    for (int j = 0; j < 4; ++j) { v0[j] = (float)acc[ai][bj][m][0][j] * sa * sb[bj][0][j]; v1[j] = (float)acc[ai][bj][m][1][j] * sa * sb[bj][1][j]; }
                    *(u32x4*)(mix + (size_t)row * DM + u.pn * 256 + bj * 128 + wc * 32 + 8 * fq) = (u32x4){cvt_pk_bf16(v0[0], v0[1]), cvt_pk_bf16(v0[2], v0[3]), cvt_pk_bf16(v1[0], v1[1]), cvt_pk_bf16(v1[2], v1[3])}; } }
    }
};

constexpr int P7_RS = 4160;
constexpr int P7_LO = 16 * P7_RS;
__device__ __forceinline__ void p7_router(const Ctx& F, const Args& A, bool dummy) {
    const float* x = A.in[I_X]; const bf16_t* mix = (const bf16_t*)(F.ws + WS_MIX); bf16_t* x1b = (bf16_t*)(F.ws + WS_X1); signed char* H2 = (signed char*)(F.ws + WS_H2);
    const int fr = F.lane & 15, fq = F.lane >> 4;
    f32x4 xr[2][8]; u32x2 mr[2][8];
#define P7_LOAD1(tile_, rr) do { const size_t ro_ = (size_t)((tile_) * 16 + 2 * F.wave + (rr)) * DM + F.lane * 4; \
        _Pragma("unroll") for (int j = 0; j < 8; ++j) { xr[rr][j] = __builtin_nontemporal_load((const f32x4*)(x + ro_ + 256 * j)); mr[rr][j] = __builtin_nontemporal_load((const u32x2*)(mix + ro_ + 256 * j)); } } while (0)
#define P7_LOAD(tile_) do { P7_LOAD1(tile_, 0); P7_LOAD1(tile_, 1); } while (0)
    LAS float* modl = (LAS float*)(F.lds + 133120);
    LAS float* rb = (LAS float*)(F.lds + 157696);
    if (F.tid < 32) rb[F.tid] = A.in[I_BRE][F.tid]; else if (F.tid < 36) rb[F.tid] = A.in[I_BRG][F.tid - 32];
    const int TPW = (NTOK / 16 + F.G - 1) / F.G, tend = ((F.vcu + 1) * TPW < NTOK / 16) ? (F.vcu + 1) * TPW : NTOK / 16;
    int tile = F.vcu * TPW, curb = -1;
    if (tile < tend) P7_LOAD(tile);
    for (; tile < tend; ++tile) {
        const int r0 = tile * 16, b = r0 >> 11;
        if (b != curb) { curb = b; __syncthreads();
            const f32x4* msrc = (const f32x4*)((const float*)(F.ws + WS_MODF) + (size_t)b * 4 * DM);
#pragma unroll
            for (int k = 0; k < 3; ++k) *(LAS f32x4*)(modl + (F.tid + 512 * k) * 4) = msrc[F.tid + 512 * k];
            __syncthreads(); }
        const LAS float* modf = modl;
#pragma unroll
        for (int rr = 0; rr < 2; ++rr) { const int rl = 2 * F.wave + rr; const size_t ro = (size_t)(r0 + rl) * DM + F.lane * 4;
            f32x4 z[8]; float s = 0.f;
#pragma unroll
            for (int j = 0; j < 8; ++j) { const f32x4 m = (f32x4){bf_lo(mr[rr][j].x), bf_hi(mr[rr][j].x), bf_lo(mr[rr][j].y), bf_hi(mr[rr][j].y)};
                s += (m.x * m.x + m.y * m.y) + (m.z * m.z + m.w * m.w); z[j] = m * *(const LAS f32x4*)(modf + F.lane * 4 + 256 * j); }
            s = wave_sum(s);
            const float rs_mix = 1.0f / sqrtf(s * (1.0f / DM) + EPS); float s1 = 0.f;
#pragma unroll
            for (int j = 0; j < 8; ++j) { z[j] = xr[rr][j] + z[j] * rs_mix; s1 += (z[j].x * z[j].x + z[j].y * z[j].y) + (z[j].z * z[j].z + z[j].w * z[j].w); __builtin_nontemporal_store((u32x2){cvt_pk_bf16(z[j].x, z[j].y), cvt_pk_bf16(z[j].z, z[j].w)}, (u32x2*)(x1b + ro + 256 * j)); }
            if (tile + 1 < tend) P7_LOAD1(tile + 1, rr);
            s1 = wave_sum(s1);
            const float rs_x1 = 1.0f / sqrtf(s1 * (1.0f / DM) + EPS);
            float mx = 0.f;
#pragma unroll
            for (int j = 0; j < 8; ++j) { const int col = F.lane * 4 + 256 * j;
                const f32x4 h = z[j] * rs_x1 * *(const LAS f32x4*)(modf + DM + col) + *(const LAS f32x4*)(modf + 2 * DM + col); z[j] = h;
                mx = fmaxf(fmaxf(mx, fmaxf(fabsf(h.x), fabsf(h.y))), fmaxf(fabsf(h.z), fabsf(h.w)));
                const u32x2 hi = (u32x2){cvt_pk_bf16(h.x, h.y), cvt_pk_bf16(h.z, h.w)};
                const u32x2 lo = (u32x2){cvt_pk_bf16(h.x - bf_lo(hi.x), h.y - bf_hi(hi.x)), cvt_pk_bf16(h.z - bf_lo(hi.y), h.w - bf_hi(hi.y))};
                *(LAS u32x2*)(F.lds + rl * P7_RS + col * 2) = hi; *(LAS u32x2*)(F.lds + P7_LO + rl * P7_RS + col * 2) = lo; }
            mx = wave_max(mx);
            mx = fmaxf(mx, 1e-20f); const float inv = 127.0f / mx;
            if (F.lane == 0) ((float*)(F.ws + WS_SAH))[r0 + rl] = mx * (1.0f / 127.0f);
#pragma unroll
            for (int j = 0; j < 8; ++j) *(unsigned*)(H2 + ro + 256 * j) = q8x4m(z[j], inv); }
        __syncthreads();
        f32x4 lacc[3] = {(f32x4){0.f, 0.f, 0.f, 0.f}, (f32x4){0.f, 0.f, 0.f, 0.f}, (f32x4){0.f, 0.f, 0.f, 0.f}};
        const u32x4* wrf = (const u32x4*)(F.ws + WS_WRF) + F.lane;
#pragma unroll 2
        for (int q = 0; q < 8; ++q) { const int ks = F.wave * 8 + q;
            const bf16x8 ahi = *(const LAS bf16x8*)(F.lds + fr * P7_RS + (ks * 32 + fq * 8) * 2), alo = *(const LAS bf16x8*)(F.lds + P7_LO + fr * P7_RS + (ks * 32 + fq * 8) * 2);
#pragma unroll
            for (int nt3 = 0; nt3 < 3; ++nt3) { const u32x4 wh = wrf[(size_t)((ks * 3 + nt3) * 2 + 0) * 64], wl = wrf[(size_t)((ks * 3 + nt3) * 2 + 1) * 64];
                const bf16x8 bh = *reinterpret_cast<const bf16x8*>(&wh), bl = *reinterpret_cast<const bf16x8*>(&wl);
                lacc[nt3] = __builtin_amdgcn_mfma_f32_16x16x32_bf16(ahi, bh, lacc[nt3], 0, 0, 0);
                lacc[nt3] = __builtin_amdgcn_mfma_f32_16x16x32_bf16(alo, bh, lacc[nt3], 0, 0, 0);
                lacc[nt3] = __builtin_amdgcn_mfma_f32_16x16x32_bf16(ahi, bl, lacc[nt3], 0, 0, 0); } }
        __syncthreads();
        LAS float* lg = (LAS float*)(F.lds + F.wave * 4096);
#pragma unroll
        for (int nt3 = 0; nt3 < 3; ++nt3)
#pragma unroll
            for (int r = 0; r < 4; ++r) lg[((F.lane >> 4) * 4 + r) * 49 + nt3 * 16 + (F.lane & 15)] = lacc[nt3][r];
        __syncthreads();
        if (F.tid < 16) {
            const LAS float* L = (const LAS float*)F.lds + F.tid * 49; const int trow = r0 + F.tid;
            float gl[4]; float gm = -3.0e38f; int gi = 0;
#pragma unroll
            for (int i = 0; i < 4; ++i) { float v = rb[32 + i];
#pragma unroll
                for (int w = 0; w < 8; ++w) v += L[w * 1024 + 32 + i];
                gl[i] = v; if (v > gm) { gm = v; gi = i; } }
            float gz = 0.f;
#pragma unroll
            for (int i = 0; i < 4; ++i) gz += fexp2((gl[i] - gm) * 1.4426950408889634f);
            const float p_top = 1.0f / gz;
            float m0 = -3.0e38f, m1 = -3.0e38f; int i0 = 0, i1 = 0;
#pragma unroll
            for (int i = 0; i < 8; ++i) { float v = rb[gi * 8 + i];
#pragma unroll
                for (int w = 0; w < 8; ++w) v += L[w * 1024 + gi * 8 + i];
                if (v > m0) { m1 = m0; i1 = i0; m0 = v; i0 = i; } else if (v > m1) { m1 = v; i1 = i; } }
            const float r = fexp2((m1 - m0) * 1.4426950408889634f);
            const float w0 = p_top / (1.0f + r), w1 = p_top * r / (1.0f + r);
            const int e0 = gi * 8 + i0, e1 = gi * 8 + i1;
            unsigned* cntb = F.ctl + CW_CNT; (void)dummy;
            const unsigned sl0 = __hip_atomic_fetch_add(cntb + 64 * e0, 1u, RLX_AGENT);
            const unsigned sl1 = __hip_atomic_fetch_add(cntb + 64 * e1, 1u, RLX_AGENT);
            int* ltok = (int*)(F.ws + WS_LTOK); float* lw = (float*)(F.ws + WS_LW); int* ts = (int*)(F.ws + WS_TSLOT);
            ltok[e0 * CAP + sl0] = trow; lw[e0 * CAP + sl0] = w0; ltok[e1 * CAP + sl1] = trow; lw[e1 * CAP + sl1] = w1;
            ts[trow * 2] = e0 * CAP + (int)sl0; ts[trow * 2 + 1] = e1 * CAP + (int)sl1;
        }
        __syncthreads();
    }
#undef P7_LOAD
#undef P7_LOAD1
}

__device__ __forceinline__ int moe_tables(const Ctx& F, bool rows) {
    LAS int* cnt = (LAS int*)(F.lds + TAB_CNT); LAS int* tbase = (LAS int*)(F.lds + TAB_TBASE); LAS int* tilee = (LAS int*)(F.lds + TAB_TILEE);
    LAS int* ud = (LAS int*)(F.lds + TAB_UDESC);
    if (F.tid < 32) cnt[F.tid] = (int)__hip_atomic_load(F.ctl + CW_CNT + 64 * F.tid, RLX_AGENT);
    __syncthreads();
    if (F.tid == 0) { int s = 0; for (int e = 0; e < 32; ++e) { tbase[e] = s; s += (cnt[e] + 255) >> 8; } tbase[32] = s; }
    __syncthreads();
    const int T = tbase[32];
    if (F.tid < T && F.tid < 160) { int e = 0; for (int q = 1; q < 32; ++q) if (tbase[q] <= F.tid) e = q; tilee[F.tid] = e; }
    __syncthreads();
    int nu = (8 * T - F.vcu + F.G - 1) / F.G; nu = nu < 0 ? 0 : (nu > MAXU ? MAXU : nu);
    int tokv[MAXU]; float wv[MAXU]; int tv_[MAXU];
#pragma unroll
    for (int i = 0; i < MAXU; ++i) { tokv[i] = 0; wv[i] = 0.f; tv_[i] = 0;
        if (i < nu) { const int L = i * F.G + F.vcu; const int t = L >> 3, pn = L & 7, e = tilee[t], rowb = (t - tbase[e]) * 256; int nv = cnt[e] - rowb; nv = nv > 256 ? 256 : nv; tv_[i] = t;
            if (F.tid == 0) { ud[i * 4 + 0] = t; ud[i * 4 + 1] = pn; ud[i * 4 + 2] = e; ud[i * 4 + 3] = nv; }
            if (rows && F.tid < 256) { const int r = F.tid < nv ? F.tid : 0; tokv[i] = ((const int*)(F.ws + WS_LTOK))[(size_t)e * CAP + rowb + r]; wv[i] = F.tid < nv ? ((const float*)(F.ws + WS_LW))[(size_t)e * CAP + rowb + r] : 0.f; } } }
#pragma unroll
    for (int i = 0; i < MAXU; ++i) if (i < nu && F.tid < 256) {
        if (rows) { ((LAS unsigned*)(F.lds + TAB_ROWOFF))[i * 256 + F.tid] = (unsigned)tokv[i] * (unsigned)DM; ((LAS float*)(F.lds + TAB_W))[i * 256 + F.tid] = wv[i];
            wv[i] = ((const float*)(F.ws + WS_SAH))[tokv[i]]; }
        else wv[i] = ((const float*)(F.ws + WS_SAHID))[tv_[i] * 256 + F.tid]; }
#pragma unroll
    for (int i = 0; i < MAXU; ++i) if (i < nu && F.tid < 256) ((LAS float*)(F.lds + TAB_SA))[i * 256 + F.tid] = wv[i];
    __syncthreads();
    return nu;
}
struct SchedMoe {
    const LAS int* ud; int nu; const char* A; const char* B; size_t a_tile, b_exp, b_pn; bool gather;
    __device__ __forceinline__ bool next(int i, pg8::Unit& u) const {
        if (i >= nu) return false;
        const int t = __builtin_amdgcn_readfirstlane(ud[i * 4 + 0]), pn = __builtin_amdgcn_readfirstlane(ud[i * 4 + 1]), e = __builtin_amdgcn_readfirstlane(ud[i * 4 + 2]);
        u.pm = t; u.pn = pn; u.e = e; u.slot = i; u.a = gather ? A : A + (size_t)t * a_tile; u.b = B + (size_t)e * b_exp + (size_t)pn * b_pn; return true;
    }
};
struct EpiMoeUp {
    static constexpr bool PERM = true, PRE = false;
    unsigned char* ws; unsigned* ctl;
    __device__ __forceinline__ void operator()(const i32x4 (&acc)[2][2][4][2], const pg8::Unit& u, int wr, int wc, int fr, int fq, LAS unsigned char* lds) const {
        signed char* hid = (signed char*)(ws + WS_HID); const LAS float* wt = (const LAS float*)(lds + TAB_W) + u.slot * 256; const LAS float* st = (const LAS float*)(lds + TAB_SA) + u.slot * 256;
        const float* sbp = (const float*)(ws + WS_SBGU) + (size_t)u.e * 2048 + u.pn * 256 + wc * 32 + 8 * fq;
        LAS float* M = (LAS float*)(lds + XCH_M); LAS float* R = (LAS float*)(lds + XCH_R);
        f32x4 sb[2][2];
#pragma unroll
        for (int bj = 0; bj < 2; ++bj) { sb[bj][0] = *(const f32x4*)(sbp + bj * 128); sb[bj][1] = *(const f32x4*)(sbp + bj * 128 + 4); }
        float h[8][8];
#pragma unroll
        for (int ai = 0; ai < 2; ++ai)
#pragma unroll
            for (int m = 0; m < 4; ++m) { const int r = ai * 128 + wr * 64 + m * 16 + fr; const float w = wt[r], sa = st[r]; float mx = 0.f;
#pragma unroll
                for (int n = 0; n < 2; ++n)
#pragma unroll
                    for (int j = 0; j < 4; ++j) { const float v = siluf_((float)acc[ai][0][m][n][j] * sa * sb[0][n][j]) * ((float)acc[ai][1][m][n][j] * sa * sb[1][n][j]) * w; h[ai * 4 + m][n * 4 + j] = v; mx = fmaxf(mx, fabsf(v)); }
                mx = pmax32(pmax16(mx));
                if (fq == 0) M[r * 4 + wc] = mx; }
        const int ew = __builtin_amdgcn_readfirstlane(wr * 4 + wc), tid = ew * 64 + fq * 16 + fr;
        row_max_exchange(lds, (unsigned long long*)(ws + WS_XCH) + (size_t)u.pm * 8 * 256, ctl + CW_TMO, u.pn, ew, tid, u.pn == 0 ? (float*)(ws + WS_SAHID) + u.pm * 256 : nullptr);
#pragma unroll
        for (int ai = 0; ai < 2; ++ai)
#pragma unroll
            for (int m = 0; m < 4; ++m) { const int r = ai * 128 + wr * 64 + m * 16 + fr; const float inv = 127.0f / R[r]; const int q = ai * 4 + m;
                *(u32x2*)(hid + ((size_t)u.pm * 256 + r) * DEXP + u.pn * 128 + wc * 32 + 8 * fq) =
                    (u32x2){q8x4m((f32x4){h[q][0], h[q][1], h[q][2], h[q][3]}, inv), q8x4m((f32x4){h[q][4], h[q][5], h[q][6], h[q][7]}, inv)}; }
    }
};
struct EpiMoeDown {
    static constexpr bool PERM = true, PRE = false;
    unsigned char* ws;
    __device__ __forceinline__ void operator()(const i32x4 (&acc)[2][2][4][2], const pg8::Unit& u, int wr, int wc, int fr, int fq, LAS unsigned char* lds) const {
        unsigned char* y = (unsigned char*)(ws + WS_Y); const LAS float* st = (const LAS float*)(lds + TAB_SA) + u.slot * 256;
        const float* sbp = (const float*)(ws + WS_SBDN) + (size_t)u.e * 2048 + u.pn * 256 + wc * 32 + 8 * fq;
        f32x4 sb[2][2];
#pragma unroll
        for (int bj = 0; bj < 2; ++bj) { sb[bj][0] = *(const f32x4*)(sbp + bj * 128) * 32.0f; sb[bj][1] = *(const f32x4*)(sbp + bj * 128 + 4) * 32.0f; }
#pragma unroll
        for (int ai = 0; ai < 2; ++ai)
#pragma unroll
            for (int m = 0; m < 4; ++m) { const int r = ai * 128 + wr * 64 + m * 16 + fr; const float sa = st[r];
#pragma unroll
                for (int bj = 0; bj < 2; ++bj) { f32x4 v0, v1;
#pragma unroll
                    for (int j = 0; j < 4; ++j) { v0[j] = fminf(fmaxf((float)acc[ai][bj][m][0][j] * sa * sb[bj][0][j], -448.0f), 448.0f); v1[j] = fminf(fmaxf((float)acc[ai][bj][m][1][j] * sa * sb[bj][1][j], -448.0f), 448.0f); }
                    int p0 = 0, p1 = 0;
                    p0 = __builtin_amdgcn_cvt_pk_fp8_f32(v0[0], v0[1], p0, false); p0 = __builtin_amdgcn_cvt_pk_fp8_f32(v0[2], v0[3], p0, true);
                    p1 = __builtin_amdgcn_cvt_pk_fp8_f32(v1[0], v1[1], p1, false); p1 = __builtin_amdgcn_cvt_pk_fp8_f32(v1[2], v1[3], p1, true);
                    *(u32x2*)(y + ((size_t)u.pm * 256 + r) * DM + u.pn * 256 + bj * 128 + wc * 32 + 8 * fq) = (u32x2){(unsigned)p0, (unsigned)p1}; } }
    }
};

__device__ __forceinline__ void p10_final(const Ctx& F, const Args& A) {
    LAS int* cnt = (LAS int*)(F.lds + TAB_CNT); LAS int* tbase = (LAS int*)(F.lds + TAB_TBASE);
    if (F.tid < 32) cnt[F.tid] = (int)__hip_atomic_load(F.ctl + CW_CNT + 64 * F.tid, RLX_AGENT);
    __syncthreads();
    if (F.tid == 0) { int s = 0; for (int e = 0; e < 32; ++e) { tbase[e] = s; s += (cnt[e] + 255) >> 8; } tbase[32] = s; }
    __syncthreads();
    const int gw = F.vcu * NWAVES + F.wave, NGW = F.G * NWAVES;
    const unsigned char* Y = (const unsigned char*)(F.ws + WS_Y); const int* ts = (const int*)(F.ws + WS_TSLOT); float* out = A.out; const bf16_t* x1b = (const bf16_t*)(F.ws + WS_X1);
    int ya[8], yb[8], yan[8], ybn[8]; u32x2 xq[8], xqn[8]; f32x4 gq[8], gqn[8];
#define P10_DATA(row_, t0_, t1_, YA, YB, XQ, GQ) do { const size_t y0_ = (size_t)(tbase[(t0_) >> 14] * 256 + ((t0_) & (CAP - 1))), y1_ = (size_t)(tbase[(t1_) >> 14] * 256 + ((t1_) & (CAP - 1))); \
        const float* g2p_ = (const float*)(F.ws + WS_MODF) + (size_t)(((row_) >> 11) * 4 + 3) * DM; \
        _Pragma("unroll") for (int j = 0; j < 8; ++j) { const int col_ = F.lane * 4 + 256 * j; YA[j] = __builtin_nontemporal_load((const int*)(Y + y0_ * DM + col_)); YB[j] = __builtin_nontemporal_load((const int*)(Y + y1_ * DM + col_)); \
            XQ[j] = __builtin_nontemporal_load((const u32x2*)(x1b + (size_t)(row_) * DM + col_)); GQ[j] = *(const f32x4*)(g2p_ + col_); } } while (0)
    int row = gw; if (row >= NTOK) return;
    int c0 = ts[row * 2], c1 = ts[row * 2 + 1];
    int n0 = 0, n1 = 0; if (row + NGW < NTOK) { n0 = ts[(row + NGW) * 2]; n1 = ts[(row + NGW) * 2 + 1]; }
    P10_DATA(row, c0, c1, ya, yb, xq, gq);
    for (; row < NTOK; row += NGW) {
        int m0 = 0, m1 = 0; if (row + 2 * NGW < NTOK) { m0 = ts[(row + 2 * NGW) * 2]; m1 = ts[(row + 2 * NGW) * 2 + 1]; }
        if (row + NGW < NTOK) P10_DATA(row + NGW, n0, n1, yan, ybn, xqn, gqn);
        f32x4 v[8]; float sq = 0.f;
#pragma unroll
        for (int j = 0; j < 8; ++j) { const f32x2 a0 = __builtin_amdgcn_cvt_pk_f32_fp8(ya[j], false), a1 = __builtin_amdgcn_cvt_pk_f32_fp8(ya[j], true), b0 = __builtin_amdgcn_cvt_pk_f32_fp8(yb[j], false), b1 = __builtin_amdgcn_cvt_pk_f32_fp8(yb[j], true);
            v[j] = (f32x4){a0.x + b0.x, a0.y + b0.y, a1.x + b1.x, a1.y + b1.y};
            sq += (v[j].x * v[j].x + v[j].y * v[j].y) + (v[j].z * v[j].z + v[j].w * v[j].w); }
        sq = wave_sum(sq);
        const float rstd = 1.0f / sqrtf(sq * (1.0f / DM) + EPS * 1024.0f);
#pragma unroll
        for (int j = 0; j < 8; ++j) { const int col = F.lane * 4 + 256 * j; const u32x2 xb = xq[j];
            __builtin_nontemporal_store((f32x4){bf_lo(xb.x), bf_hi(xb.x), bf_lo(xb.y), bf_hi(xb.y)} + gq[j] * v[j] * rstd, (f32x4*)(out + (size_t)row * DM + col)); }
#pragma unroll
        for (int j = 0; j < 8; ++j) { ya[j] = yan[j]; yb[j] = ybn[j]; xq[j] = xqn[j]; gq[j] = gqn[j]; }
        n0 = m0; n1 = m1;
    }
#undef P10_DATA
}

__global__ void __launch_bounds__(NTHR, 2) fwd_kernel(Args args) {
    extern __shared__ __attribute__((aligned(16))) unsigned char lds[];
    Ctx F;
    F.lds = (LAS unsigned char*)lds; F.ws = args.ws; F.ctl = (unsigned*)(args.ws + WS_CTL);
    F.tid = threadIdx.x; F.lane = F.tid & 63; F.wave = __builtin_amdgcn_readfirstlane(F.tid >> 6);
    F.G = gridDim.x; F.bx = blockIdx.x; F.vcu = (F.G % 8 == 0) ? (F.bx % 8) * (F.G / 8) + F.bx / 8 : F.bx;
    const int lo = args.ph_lo, hi = args.ph_hi;
    if (F.tid < 16) ((LAS unsigned*)(F.lds + LDS_MISC))[F.tid] = 0u;
    __syncthreads();
    XcdBarrier bar; bar.bar = (unsigned*)(F.ctl + CW_BAR); bar.x = 0; bar.st = nullptr;
    if (hi - lo > 1) bar = xcd_barrier_post((unsigned*)(F.ctl + CW_BAR), (volatile LAS unsigned*)(F.lds + LDS_MISC + 32));
int rep0 = 0, rep4 = 0, rep7 = 0;
#define IN(k) (lo <= (k) && (k) < hi)
#define SEAM(k) do { if (IN(k) && IN((k) + 1)) xcd_barrier(bar); } while (0)

#ifndef DUP_PHASE
#define DUP_PHASE -1
#endif
#define RUN(k, ...) do { if (IN(k)) { __VA_ARGS__ if (DUP_PHASE == (k)) { xcd_barrier(bar); __VA_ARGS__ } } SEAM(k); } while (0)
    RUN(0, { p0_prologue(F, args, rep0++); });
    RUN(1, { p1_rows(F, args); });
    RUN(2, { SchedInProj S{(const char*)(F.ws + WS_HX), (const char*)(F.ws + WS_WIN), F.G, F.bx}; EpiInProj E{F.ws, args.in[I_QNORM], args.in[I_KNORM]};
        pg8::gemm_phase<2048, true, false, true>(F.lds, S, E); });
    RUN(4, { p4_attention(F, args, (char*)lds, rep4++); });
    RUN(5, { p5_quant_rows(F); xcd_barrier(bar);
        SchedF1 S{F.ws, F.G, F.bx}; EpiF1 E{F.ws, F.ctl};
        pg8::gemm_phase<1024, true, false, true>(F.lds, S, E); });
    RUN(6, { SchedF2 S{F.ws, F.G, F.bx}; EpiF2 E{F.ws};
        pg8::gemm_phase<2048, true, false, true>(F.lds, S, E); });
    RUN(7, { p7_router(F, args, (DUP_PHASE == 7) && (rep7++ == 0)); });
    RUN(8, { const int nu = moe_tables(F, true);
        SchedMoe S{(const LAS int*)(F.lds + TAB_UDESC), nu, (const char*)(F.ws + WS_H2), (const char*)(F.ws + WS_WGU), 0, (size_t)2048 * 2048, (size_t)256 * 2048, true}; EpiMoeUp E{F.ws, F.ctl};
        pg8::gemm_phase<2048, true, true, true>(F.lds, S, E); });
    RUN(9, { const int nu = moe_tables(F, false);
        SchedMoe S{(const LAS int*)(F.lds + TAB_UDESC), nu, (const char*)(F.ws + WS_HID), (const char*)(F.ws + WS_WDN), (size_t)256 * 1024, (size_t)2048 * 1024, (size_t)256 * 1024, false}; EpiMoeDown E{F.ws};
        pg8::gemm_phase<1024, true, false, true>(F.lds, S, E); });
    RUN(10, { p10_final(F, args); });
#undef RUN
#undef IN
#undef SEAM
}

extern "C" void kernel_launch(void* const* d_in, const int* in_sizes, int n_in, void* d_out, int out_size, void* d_ws, size_t ws_size, hipStream_t stream) {
    static int grid = 0;
    if (grid == 0) {
        if (n_in != 26 || in_sizes[0] != NTOK * DM || out_size != NTOK * DM || ws_size < WS_END2) {
            fprintf(stderr, "kernel_launch: shape/workspace mismatch: n_in %d in0 %d out %d ws %zu (need %zu)\n", n_in, n_in > 0 ? in_sizes[0] : -1, out_size, ws_size, (size_t)WS_END2); grid = -1; return; }
        int dev = 0, cus = 0, per_cu = 0;
        if (hipGetDevice(&dev) != hipSuccess || hipDeviceGetAttribute(&cus, hipDeviceAttributeMultiprocessorCount, dev) != hipSuccess) { grid = -1; return; }
        if (hipFuncSetAttribute((const void*)fwd_kernel, hipFuncAttributeMaxDynamicSharedMemorySize, LDS_BYTES) != hipSuccess) { fprintf(stderr, "kernel_launch: hipFuncSetAttribute failed\n"); grid = -1; return; }
        if (hipOccupancyMaxActiveBlocksPerMultiprocessor(&per_cu, (const void*)fwd_kernel, NTHR, LDS_BYTES) != hipSuccess || per_cu < 1)
            fprintf(stderr, "kernel_launch: occupancy query reports %d workgroups per CU\n", per_cu);
        (void)hipGetLastError();
        grid = cus;
        if (grid != 256) fprintf(stderr, "kernel_launch: note: %d CUs\n", grid);
    }
    if (grid < 0) return;
    if (hipMemsetAsync((char*)d_ws + WS_CTL, 0, CTL_ZERO_BYTES, stream) != hipSuccess) { fprintf(stderr, "kernel_launch: memset failed\n"); return; }
    Args a{};
    for (int i = 0; i < 26; ++i) a.in[i] = (const float*)d_in[i];
    a.out = (float*)d_out; a.ws = (unsigned char*)d_ws;
#if MK_N_LAUNCHES == 1
    a.ph_lo = 0; a.ph_hi = N_PHASES;
    hipLaunchKernelGGL(fwd_kernel, dim3(grid), dim3(NTHR), LDS_BYTES, stream, a);
#else
    for (int p = 0; p < N_PHASES; ++p) { a.ph_lo = p; a.ph_hi = p + 1; hipLaunchKernelGGL(fwd_kernel, dim3(grid), dim3(NTHR), LDS_BYTES, stream, a); }
#endif
    const hipError_t le = hipPeekAtLastError();
    if (le != hipSuccess) fprintf(stderr, "kernel_launch: launch failed: %s\n", hipGetErrorName(le));
}
```
